# Optimizing an MI355X kernel written in HIP

```python
import math
import jax, jax.numpy as jnp
from jax import lax
import numpy as np

D_MODEL = 1024
BATCH = 4
SEQ = 8192
DEPTH = 4
DEC_BATCH = 8
DEC_SEQ = 8192
PAST_LEN = 128

GRID_W = 64
N_EVEN = (DEPTH + 1) // 2
N_ODD = DEPTH // 2
D_RET = D_MODEL // 2
RET_HEADS = 4
RET_HEAD_DIM = D_RET // RET_HEADS
RET_CHUNK = 128
D_SSM = D_MODEL - D_RET
SSM_GROUP = 16
SSM_GROUPS = D_SSM // SSM_GROUP
SSM_STATE = 64
EVEN_IN = 4 * D_RET + 2 * D_SSM
D_NA = D_MODEL
NA_HEADS = 16
NA_HEAD_DIM = D_NA // NA_HEADS
NA_ROWS_MAX = 8
NA_COLS = 16
ODD_IN = 4 * D_NA
ROPE_BASE = 10000.0
EPS = 1e-6
NEG_INF = -1e30
DT_MIN = 1e-3
DT_MAX = 1e-1

kernel_name = "hybrid_retention_s5_natten_encoder"


def _rmsnorm(x, g):
    xf = x.astype(jnp.float32)
    y = xf * lax.rsqrt(jnp.mean(xf * xf, axis=-1, keepdims=True) + EPS)
    return (y * g.astype(jnp.float32)).astype(x.dtype)


def _head_norm(o):
    of = o.astype(jnp.float32)
    mu = jnp.mean(of, axis=-1, keepdims=True)
    var = jnp.mean(jnp.square(of - mu), axis=-1, keepdims=True)
    return ((of - mu) * lax.rsqrt(var + EPS)).astype(o.dtype)


def _rotary(x):
    L, dh = x.shape[1], x.shape[-1]
    inv = ROPE_BASE ** (-jnp.arange(0, dh, 2, dtype=jnp.float32) / dh)
    ang = jnp.arange(L, dtype=jnp.float32)[:, None] * inv[None, :]
    cos = jnp.cos(ang)[None, :, None, :].astype(x.dtype)
    sin = jnp.sin(ang)[None, :, None, :].astype(x.dtype)
    x1, x2 = x[..., : dh // 2], x[..., dh // 2:]
    return jnp.concatenate([x1 * cos - x2 * sin, x1 * sin + x2 * cos], axis=-1)


def _retention(q, k, v):
    B, L, H, dk = q.shape
    dv = v.shape[-1]
    dt = q.dtype
    cs = RET_CHUNK
    n = L // cs
    log_g = jnp.log1p(-jnp.exp2(-5.0 - jnp.arange(H, dtype=jnp.float32)))
    pos = jnp.arange(cs, dtype=jnp.float32)
    intra = jnp.exp(jnp.abs(pos[:, None] - pos[None, :])[None] * log_g[:, None, None]).astype(dt)
    q_fwd = jnp.exp(pos[:, None] * log_g[None]).astype(dt)[:, :, None]
    q_bwd = jnp.exp((cs - 1.0 - pos)[:, None] * log_g[None]).astype(dt)[:, :, None]
    k_fwd = jnp.exp((cs - pos)[:, None] * log_g[None]).astype(dt)[:, :, None]
    k_bwd = jnp.exp((pos + 1.0)[:, None] * log_g[None]).astype(dt)[:, :, None]
    chunk_decay = jnp.exp(cs * log_g).astype(dt)[None, :, None, None]

    qc = q.reshape(B, n, cs, H, dk)
    kc = k.reshape(B, n, cs, H, dk)
    vc = v.reshape(B, n, cs, H, dv)
    s = jnp.einsum('bnihd,bnjhd->bnhij', qc, kc) * intra
    o = jnp.einsum('bnhij,bnjhe->bnihe', s, vc)

    kv_f = jnp.einsum('bnjhd,bnjhe->nbhde', kc * k_fwd, vc)
    kv_b = jnp.einsum('bnjhd,bnjhe->nbhde', kc * k_bwd, vc)

    def step(carry, kv):
        return chunk_decay * carry + kv, carry

    init = jnp.zeros((B, H, dk, dv), dt)
    _, st_f = lax.scan(step, init, kv_f)
    _, st_b = lax.scan(step, init, kv_b, reverse=True)
    o = (o + jnp.einsum('bnihd,nbhde->bnihe', qc * q_fwd, st_f)
         + jnp.einsum('bnihd,nbhde->bnihe', qc * q_bwd, st_b))
    return o.reshape(B, L, H, dv)


def _cplx_combine(e_i, e_j):
    ar_i, ai_i, br_i, bi_i = e_i
    ar_j, ai_j, br_j, bi_j = e_j
    ar = ar_j * ar_i - ai_j * ai_i
    ai = ar_j * ai_i + ai_j * ar_i
    br = ar_j * br_i - ai_j * bi_i + br_j
    bi = ar_j * bi_i + ai_j * br_i + bi_j
    return ar, ai, br, bi


def _s5_scan(u, a_re, a_im, log_step, b_re, b_im, c_re, c_im, reverse):
    f32 = jnp.float32
    a_re = a_re.astype(f32)
    a_im = a_im.astype(f32)
    delta = jnp.exp(log_step.astype(f32))[:, None]
    z_re, z_im = a_re * delta, a_im * delta
    mag = jnp.exp(z_re)
    abar_re, abar_im = mag * jnp.cos(z_im), mag * jnp.sin(z_im)
    den = a_re * a_re + a_im * a_im
    n_re, n_im = abar_re - 1.0, abar_im
    f_re = (n_re * a_re + n_im * a_im) / den
    f_im = (n_im * a_re - n_re * a_im) / den
    b_re = b_re.astype(f32)
    b_im = b_im.astype(f32)
    bb_re = f_re[..., None] * b_re - f_im[..., None] * b_im
    bb_im = f_re[..., None] * b_im + f_im[..., None] * b_re
    bu_re = jnp.einsum('blgi,gpi->blgp', u, bb_re)
    bu_im = jnp.einsum('blgi,gpi->blgp', u, bb_im)
    shape = (1, u.shape[1]) + abar_re.shape
    elems = (jnp.broadcast_to(abar_re[None, None], shape),
             jnp.broadcast_to(abar_im[None, None], shape), bu_re, bu_im)
    _, _, x_re, x_im = lax.associative_scan(_cplx_combine, elems, reverse=reverse, axis=1)
    return (jnp.einsum('blgp,gip->blgi', x_re, c_re.astype(f32))
            - jnp.einsum('blgp,gip->blgi', x_im, c_im.astype(f32)))


def _s5(u, a_re, a_im, log_step, b_re, b_im, c_re, c_im, d_skip, w_glu):
    B, L, _ = u.shape
    dt = u.dtype
    uf = u.astype(jnp.float32)
    ug = uf.reshape(B, L, SSM_GROUPS, SSM_GROUP)
    y = (_s5_scan(ug, a_re[0], a_im[0], log_step[0], b_re[0], b_im[0], c_re[0], c_im[0], False)
         + _s5_scan(ug, a_re[1], a_im[1], log_step[1], b_re[1], b_im[1], c_re[1], c_im[1], True))
    y = y.reshape(B, L, D_SSM) + d_skip.astype(jnp.float32) * uf
    y = jax.nn.gelu(y)
    y = y * jax.nn.sigmoid(y @ w_glu.astype(jnp.float32))
    return y.astype(dt)


def _neighbourhood_attention(q, k, v, rel_bias):
    B, L, H, dh = q.shape
    rows = L // GRID_W
    kr = min(NA_ROWS_MAX, rows)
    q = q.reshape(B, rows, GRID_W, H, dh)
    k = k.reshape(B, rows, GRID_W, H, dh)
    v = v.reshape(B, rows, GRID_W, H, dh)
    r_idx = jnp.arange(rows)
    row_start = jnp.clip(r_idx - kr // 2, 0, rows - kr)
    c_idx = jnp.arange(GRID_W)
    col_start = jnp.clip(c_idx - NA_COLS // 2, 0, GRID_W - NA_COLS)
    col_valid = ((c_idx[None, :] >= col_start[:, None])
                 & (c_idx[None, :] < col_start[:, None] + NA_COLS))
    dc_idx = jnp.clip(c_idx[None, :] - c_idx[:, None] + NA_COLS - 1, 0, 2 * NA_COLS - 2)
    col_bias = jnp.take(rel_bias.astype(jnp.float32), dc_idx, axis=2)
    scale = dh ** -0.5

    def one_row(r):
        rows_k = row_start[r] + jnp.arange(kr)
        kb = jnp.take(k, rows_k, axis=1)
        vb = jnp.take(v, rows_k, axis=1)
        qr = lax.dynamic_index_in_dim(q, r, axis=1, keepdims=False)
        s = jnp.einsum('bqhd,brkhd->bhqrk', qr, kb).astype(jnp.float32) * scale
        bias = jnp.take(col_bias, rows_k - r + NA_ROWS_MAX - 1, axis=1)
        s = s + jnp.transpose(bias, (0, 2, 1, 3))[None]
        s = jnp.where(col_valid[:, None, :], s, NEG_INF)
        p = jax.nn.softmax(s.reshape(B, H, GRID_W, kr * GRID_W), axis=-1)
        p = p.reshape(B, H, GRID_W, kr, GRID_W).astype(v.dtype)
        return jnp.einsum('bhqrk,brkhd->bqhd', p, vb)

    out = lax.map(one_row, r_idx)
    return jnp.moveaxis(out, 0, 1).reshape(B, L, H * dh)


def _even_mixer(h, w_in, w_out, a_re, a_im, log_step, b_re, b_im, c_re, c_im, d_skip, w_glu):
    B, L, _ = h.shape
    z = h @ w_in
    q, k, v, ga, ub, gb = jnp.split(
        z, [D_RET, 2 * D_RET, 3 * D_RET, 4 * D_RET, 4 * D_RET + D_SSM], axis=-1)
    hs = (B, L, RET_HEADS, RET_HEAD_DIM)
    q = _rotary(q.reshape(hs))
    k = _rotary(k.reshape(hs)) * (RET_HEAD_DIM ** -0.5)
    o_a = _head_norm(_retention(q, k, v.reshape(hs))).reshape(B, L, D_RET) * jax.nn.silu(ga)
    o_b = _s5(ub, a_re, a_im, log_step, b_re, b_im, c_re, c_im, d_skip, w_glu) * jax.nn.silu(gb)
    return jnp.concatenate([o_a, o_b], axis=-1) @ w_out


def _odd_mixer(h, w_in, w_out, rel_bias):
    B, L, _ = h.shape
    q, k, v, g = jnp.split(h @ w_in, 4, axis=-1)
    hs = (B, L, NA_HEADS, NA_HEAD_DIM)
    o = _neighbourhood_attention(q.reshape(hs), k.reshape(hs), v.reshape(hs), rel_bias)
    return (o * jax.nn.silu(g)) @ w_out


def _trunk(x, c, norm_pre, norm_post, w_mod, b_mod, w_in_ab, w_out_ab,
           ssm_a_re, ssm_a_im, ssm_log_step, ssm_b_re, ssm_b_im, ssm_c_re, ssm_c_im,
           ssm_d, ssm_w_glu, w_in_c, w_out_c, na_rel_bias):
    for i in range(DEPTH):
        mod = jax.nn.silu(c) @ w_mod[i] + b_mod[i]
        shift, scale, gate = jnp.split(mod[:, None, :], 3, axis=-1)
        h = _rmsnorm(x, norm_pre[i]) * (1.0 + scale) + shift
        j = i // 2
        if i % 2 == 0:
            y = _even_mixer(h, w_in_ab[j], w_out_ab[j], ssm_a_re[j], ssm_a_im[j],
                            ssm_log_step[j], ssm_b_re[j], ssm_b_im[j], ssm_c_re[j],
                            ssm_c_im[j], ssm_d[j], ssm_w_glu[j])
        else:
            y = _odd_mixer(h, w_in_c[j], w_out_c[j], na_rel_bias[j])
        x = x + gate * _rmsnorm(y, norm_post[i])
    return x


def setup_inputs(seed: int = 0) -> dict:
    key = jax.random.key(seed)
    ks = jax.random.split(key, 24)
    f32 = jnp.float32
    nrm = lambda k, s, sc: jax.random.normal(k, s, f32) * sc
    G, P, Gi = SSM_GROUPS, SSM_STATE, SSM_GROUP
    return {
        "x_prompt": nrm(ks[0], (BATCH, SEQ, D_MODEL), 1.0),
        "x_sample": nrm(ks[1], (DEC_BATCH, DEC_SEQ, D_MODEL), 1.0),
        "c_prompt": nrm(ks[2], (BATCH, D_MODEL), 1.0),
        "c_sample": nrm(ks[3], (DEC_BATCH, D_MODEL), 1.0),
        "norm_pre": 1.0 + nrm(ks[4], (DEPTH, D_MODEL), 0.05),
        "norm_post": 1.0 + nrm(ks[5], (DEPTH, D_MODEL), 0.05),
        "w_mod": nrm(ks[6], (DEPTH, D_MODEL, 3 * D_MODEL), 0.5 * D_MODEL ** -0.5),
        "b_mod": nrm(ks[7], (DEPTH, 3 * D_MODEL), 0.02),
        "w_in_ab": nrm(ks[8], (N_EVEN, D_MODEL, EVEN_IN), D_MODEL ** -0.5),
        "w_out_ab": nrm(ks[9], (N_EVEN, D_RET + D_SSM, D_MODEL), (D_RET + D_SSM) ** -0.5),
        "ssm_a_re": -0.5 + nrm(ks[10], (N_EVEN, 2, G, P), 0.01),
        "ssm_a_im": math.pi * jnp.arange(P, dtype=f32) + nrm(ks[11], (N_EVEN, 2, G, P), 0.01),
        "ssm_log_step": jax.random.uniform(ks[12], (N_EVEN, 2, G), f32,
                                           math.log(DT_MIN), math.log(DT_MAX)),
        "ssm_b_re": nrm(ks[13], (N_EVEN, 2, G, P, Gi), (2 * Gi) ** -0.5),
        "ssm_b_im": nrm(ks[14], (N_EVEN, 2, G, P, Gi), (2 * Gi) ** -0.5),
        "ssm_c_re": nrm(ks[15], (N_EVEN, 2, G, Gi, P), P ** -0.5),
        "ssm_c_im": nrm(ks[16], (N_EVEN, 2, G, Gi, P), P ** -0.5),
        "ssm_d": nrm(ks[17], (N_EVEN, D_SSM), 0.5),
        "ssm_w_glu": nrm(ks[18], (N_EVEN, D_SSM, D_SSM), D_SSM ** -0.5),
        "w_in_c": nrm(ks[19], (N_ODD, D_MODEL, ODD_IN), D_MODEL ** -0.5),
        "w_out_c": nrm(ks[20], (N_ODD, D_NA, D_MODEL), D_NA ** -0.5),
        "na_rel_bias": nrm(ks[21], (N_ODD, NA_HEADS, 2 * NA_ROWS_MAX - 1, 2 * NA_COLS - 1), 0.1),
    }


def reference(x_prompt, x_sample, c_prompt, c_sample, norm_pre, norm_post, w_mod, b_mod,
              w_in_ab, w_out_ab, ssm_a_re, ssm_a_im, ssm_log_step, ssm_b_re, ssm_b_im,
              ssm_c_re, ssm_c_im, ssm_d, ssm_w_glu, w_in_c, w_out_c, na_rel_bias):
    y_prompt = _trunk(x_prompt, c_prompt, norm_pre, norm_post, w_mod, b_mod, w_in_ab, w_out_ab,
                      ssm_a_re, ssm_a_im, ssm_log_step, ssm_b_re, ssm_b_im, ssm_c_re, ssm_c_im,
                      ssm_d, ssm_w_glu, w_in_c, w_out_c, na_rel_bias)
    y_sample = _trunk(x_sample, c_sample, norm_pre, norm_post, w_mod, b_mod, w_in_ab, w_out_ab,
                      ssm_a_re, ssm_a_im, ssm_log_step, ssm_b_re, ssm_b_im, ssm_c_re, ssm_c_im,
                      ssm_d, ssm_w_glu, w_in_c, w_out_c, na_rel_bias)
    return (y_prompt, y_sample)
```

```cpp
#include <hip/hip_runtime.h>
#include <hip/hip_cooperative_groups.h>
#include <cstdio>
#include <cstdint>
namespace cg = cooperative_groups;

typedef unsigned short bf16_t;
typedef short bf16x8 __attribute__((ext_vector_type(8)));
typedef float f32x4 __attribute__((ext_vector_type(4)));
typedef float f32x16 __attribute__((ext_vector_type(16)));
typedef unsigned u32x4 __attribute__((ext_vector_type(4)));

constexpr int T_TOK = 98304, SEQL = 8192, DM = 1024;
constexpr float EPSF = 1e-6f;

constexpr size_t OFF_Z = 0;
constexpr size_t SZ_Z = 805306368ull;
constexpr size_t OFF_B = OFF_Z + SZ_Z;
constexpr size_t SZ_B = 201326592ull;
constexpr size_t OFF_W = OFF_B + SZ_B;
constexpr size_t W_IN_AB = 0;
constexpr size_t W_OUT_AB = W_IN_AB + 2ull * 3145728;
constexpr size_t W_GLU = W_OUT_AB + 2ull * 1048576;
constexpr size_t W_IN_C = W_GLU + 2ull * 262144;
constexpr size_t W_OUT_C = W_IN_C + 2ull * 4194304;
constexpr size_t W_TOTAL = W_OUT_C + 2ull * 1048576;
constexpr size_t OFF_MOD = OFF_W + W_TOTAL * 2;
constexpr size_t OFF_COS = OFF_MOD + 4ull * 12 * 3072 * 4;
constexpr size_t OFF_SIN = OFF_COS + 8192ull * 64 * 4;
constexpr size_t WS_END = OFF_SIN + 8192ull * 64 * 4;
constexpr size_t OFF_BAR = WS_END;
constexpr int ZE_LD = 2048;
constexpr size_t ZE_US = (size_t)T_TOK * ZE_LD * 2;
constexpr size_t ZE_VT = ZE_US + 100663296ull;
constexpr size_t ZE_KT = ZE_VT + 100663296ull;
constexpr size_t ZE_E = ZE_KT + 100663296ull;
constexpr size_t ZE_CARRY = ZE_E + 50331648ull;
constexpr int ZO_LD = 3072;
constexpr size_t ZO_VT = (size_t)T_TOK * ZO_LD * 2;
constexpr size_t B_YG = 0;
constexpr size_t B_KMAT = 100663296ull;
constexpr size_t B_EMAT = B_KMAT + 83886080ull;

struct Params {
    const float *x_prompt, *x_sample, *c_prompt, *c_sample, *norm_pre, *norm_post, *w_mod, *b_mod;
    const float *w_in_ab, *w_out_ab, *a_re, *a_im, *log_step, *b_re, *b_im, *c_re, *c_im, *ssm_d, *w_glu;
    const float *w_in_c, *w_out_c, *rel_bias;
    float* out;
    unsigned char* ws;
    int hb;
    int pad_;
};

__device__ __forceinline__ float bf2f(unsigned short u) { return __uint_as_float(((unsigned)u) << 16); }
__device__ __forceinline__ unsigned pk2(float lo, float hi) {
    unsigned r;
    asm("v_cvt_pk_bf16_f32 %0, %1, %2" : "=v"(r) : "v"(lo), "v"(hi));
    return r;
}
__device__ __forceinline__ bf16_t f2bf(float v) { return (bf16_t)(pk2(v, 0.f) & 0xffffu); }
__device__ __forceinline__ float sigmoidf_(float x) { return 1.f / (1.f + __expf(-x)); }
__device__ __forceinline__ float siluf_(float x) { return x / (1.f + __expf(-x)); }
__device__ __forceinline__ float gelu_tanh(float y) {
    const float u = 0.7978845608028654f * (y + 0.044715f * y * y * y);
    const float e = __expf(2.f * u);
    const float th = 1.f - 2.f / (e + 1.f);
    return 0.5f * y * (1.f + th);
}
__device__ __forceinline__ void st4(bf16_t* dst, float a, float b, float c, float d) {
    uint2 v; v.x = pk2(a, b); v.y = pk2(c, d);
    *(uint2*)dst = v;
}
__device__ __forceinline__ void ld4(const bf16_t* src, float& a, float& b, float& c, float& d) {
    const uint2 v = *(const uint2*)src;
    a = __uint_as_float(v.x << 16); b = __uint_as_float(v.x & 0xffff0000u);
    c = __uint_as_float(v.y << 16); d = __uint_as_float(v.y & 0xffff0000u);
}
__device__ __forceinline__ uint4 scale8(uint4 v, float s) {
    uint4 o;
    o.x = pk2(__uint_as_float(v.x << 16) * s, __uint_as_float(v.x & 0xffff0000u) * s);
    o.y = pk2(__uint_as_float(v.y << 16) * s, __uint_as_float(v.y & 0xffff0000u) * s);
    o.z = pk2(__uint_as_float(v.z << 16) * s, __uint_as_float(v.z & 0xffff0000u) * s);
    o.w = pk2(__uint_as_float(v.w << 16) * s, __uint_as_float(v.w & 0xffff0000u) * s);
    return o;
}
__device__ __forceinline__ const float* x_row(const Params& p, int row) {
    return row < 4 * SEQL ? p.x_prompt + (size_t)row * DM : p.x_sample + (size_t)(row - 4 * SEQL) * DM;
}
__device__ __forceinline__ const float* c_row(const Params& p, int b) {
    return b < 4 ? p.c_prompt + (size_t)b * DM : p.c_sample + (size_t)(b - 4) * DM;
}
__device__ __forceinline__ float log2_gamma(int h) { return log2f(1.f - exp2f(-5.f - (float)h)); }

__device__ __forceinline__ int lane_id() { int l; asm volatile("v_mbcnt_lo_u32_b32 %0, -1, 0\n\tv_mbcnt_hi_u32_b32 %0, -1, %0" : "=v"(l)); return l; }
#define tidx() tid_of(wv & 3)
#define t512x() tid_of(wv)
__device__ __forceinline__ int tid_of(int w) { int t = w * 64 + lane_id(); asm volatile("" : "+v"(t)); return t; }
#define VB ((int)blockIdx.x * 2 + hb)
#define VG ((int)gridDim.x * 2)
constexpr int LDS_PITCH = 144;
constexpr int STAGE_B = 128 * LDS_PITCH;
constexpr int LDS_TOTAL = 4 * STAGE_B + 2048;

__device__ __forceinline__ void compute_ktile(f32x16 (&acc)[2][2], const unsigned char* Ab, const unsigned char* Bb, int tid, bool swap) {
    const int lane = tid & 63, wave = tid >> 6, wm = wave >> 1, wn = wave & 1;
    const int l31 = lane & 31, half = lane >> 5;
    const unsigned char* ap = Ab + (wm * 64 + l31) * LDS_PITCH + half * 16;
    const unsigned char* bp = Bb + (wn * 32 + l31) * LDS_PITCH + half * 16;
    if (swap) {
#pragma unroll
        for (int ks = 0; ks < 4; ++ks) {
            bf16x8 a[2], b[2];
            a[0] = *(const bf16x8*)(ap + ks * 32);
            a[1] = *(const bf16x8*)(ap + 32 * LDS_PITCH + ks * 32);
            b[0] = *(const bf16x8*)(bp + ks * 32);
            b[1] = *(const bf16x8*)(bp + 64 * LDS_PITCH + ks * 32);
#pragma unroll
            for (int mi = 0; mi < 2; ++mi)
#pragma unroll
                for (int nj = 0; nj < 2; ++nj) acc[mi][nj] = __builtin_amdgcn_mfma_f32_32x32x16_bf16(b[nj], a[mi], acc[mi][nj], 0, 0, 0);
        }
    } else {
#pragma unroll
        for (int ks = 0; ks < 4; ++ks) {
            bf16x8 a[2], b[2];
            a[0] = *(const bf16x8*)(ap + ks * 32);
            a[1] = *(const bf16x8*)(ap + 32 * LDS_PITCH + ks * 32);
            b[0] = *(const bf16x8*)(bp + ks * 32);
            b[1] = *(const bf16x8*)(bp + 64 * LDS_PITCH + ks * 32);
#pragma unroll
            for (int mi = 0; mi < 2; ++mi)
#pragma unroll
                for (int nj = 0; nj < 2; ++nj) acc[mi][nj] = __builtin_amdgcn_mfma_f32_32x32x16_bf16(a[mi], b[nj], acc[mi][nj], 0, 0, 0);
        }
    }
}

template <class AL, class BL>
__device__ __forceinline__ void gemm_kloop1(f32x16 (&acc)[2][2], const AL& al, const BL& bl, int nk, unsigned char* lds, int tid, bool swap = true) {
    const int srow = tid >> 3, skc = (tid & 7) * 8;
    uint4 ra[4], rb[4];
#pragma unroll
    for (int i = 0; i < 4; ++i) { ra[i] = al(srow + 32 * i, skc); rb[i] = bl(srow + 32 * i, skc); }
    __syncthreads();
#pragma unroll
    for (int i = 0; i < 4; ++i) {
        *(uint4*)(lds + (srow + 32 * i) * LDS_PITCH + skc * 2) = ra[i];
        *(uint4*)(lds + 2 * STAGE_B + (srow + 32 * i) * LDS_PITCH + skc * 2) = rb[i];
    }
    __syncthreads();
#pragma unroll 1
    for (int kt = 0; kt < nk; ++kt) {
        const int cur = kt & 1;
        const bool more = (kt + 1 < nk);
        if (more) {
            const int k = (kt + 1) * 64 + skc;
#pragma unroll
            for (int i = 0; i < 4; ++i) { ra[i] = al(srow + 32 * i, k); rb[i] = bl(srow + 32 * i, k); }
        }
        compute_ktile(acc, lds + cur * STAGE_B, lds + 2 * STAGE_B + cur * STAGE_B, tid, swap);
        if (more) {
            const int nxt = cur ^ 1;
#pragma unroll
            for (int i = 0; i < 4; ++i) {
                *(uint4*)(lds + nxt * STAGE_B + (srow + 32 * i) * LDS_PITCH + skc * 2) = ra[i];
                *(uint4*)(lds + 2 * STAGE_B + nxt * STAGE_B + (srow + 32 * i) * LDS_PITCH + skc * 2) = rb[i];
            }
        }
        __syncthreads();
    }
}

template <class AL, class BL>
__device__ __forceinline__ void gemm_kloop(f32x16 (&acc)[2][2], const AL& al, const BL& bl, int nk, unsigned char* lds, int tid, bool swap = true) {
    const int srow = tid >> 3, skc = (tid & 7) * 8;
    uint4 ra0[4], rb0[4], ra1[4], rb1[4];
#define GK_LOAD(RA, RB, KT) { const int k_ = (KT) * 64 + skc; _Pragma("unroll") for (int i = 0; i < 4; ++i) { RA[i] = al(srow + 32 * i, k_); RB[i] = bl(srow + 32 * i, k_); } }
#define GK_STORE(RA, RB, BUF) { _Pragma("unroll") for (int i = 0; i < 4; ++i) { \
        *(uint4*)(lds + (BUF) * STAGE_B + (srow + 32 * i) * LDS_PITCH + skc * 2) = RA[i]; \
        *(uint4*)(lds + 2 * STAGE_B + (BUF) * STAGE_B + (srow + 32 * i) * LDS_PITCH + skc * 2) = RB[i]; } }
    const int last = nk - 1;
    GK_LOAD(ra0, rb0, 0);
    GK_LOAD(ra1, rb1, 1);
    __syncthreads();
    GK_STORE(ra0, rb0, 0);
    GK_LOAD(ra0, rb0, (2 < last ? 2 : last));
    __syncthreads();
#pragma unroll 1
    for (int kt = 0; kt < nk; kt += 2) {
        compute_ktile(acc, lds, lds + 2 * STAGE_B, tid, swap);
        GK_STORE(ra1, rb1, 1);
        __builtin_amdgcn_sched_barrier(0);
        GK_LOAD(ra1, rb1, (kt + 3 < last ? kt + 3 : last));
        __syncthreads();
        compute_ktile(acc, lds + STAGE_B, lds + 3 * STAGE_B, tid, swap);
        GK_STORE(ra0, rb0, 0);
        __builtin_amdgcn_sched_barrier(0);
        GK_LOAD(ra0, rb0, (kt + 4 < last ? kt + 4 : last));
        __syncthreads();
    }
#undef GK_LOAD
#undef GK_STORE
}

constexpr int ST2_B = 65536;
__device__ __forceinline__ void compute_ktile256(f32x16 (&acc)[2][4], const unsigned char* Ab, const unsigned char* Bb, int t512) {
    const int lane = t512 & 63, wave = t512 >> 6, wm = wave >> 1, wn = wave & 1;
    const int l31 = lane & 31, half = lane >> 5;
    const int swz = (l31 >> 1) & 7;
    const unsigned char* ap = Ab + (wm * 64 + l31) * 128;
    const unsigned char* bp = Bb + (wn * 128 + l31) * 128;
#pragma unroll
    for (int ks = 0; ks < 4; ++ks) {
        const int off = ((ks * 2 + half) ^ swz) * 16;
        bf16x8 a[2], b[4];
        a[0] = *(const bf16x8*)(ap + off);
        a[1] = *(const bf16x8*)(ap + 32 * 128 + off);
#pragma unroll
        for (int nj = 0; nj < 4; ++nj) b[nj] = *(const bf16x8*)(bp + nj * 32 * 128 + off);
#pragma unroll
        for (int mi = 0; mi < 2; ++mi)
#pragma unroll
            for (int nj = 0; nj < 4; ++nj) acc[mi][nj] = __builtin_amdgcn_mfma_f32_32x32x16_bf16(a[mi], b[nj], acc[mi][nj], 0, 0, 0);
    }
}

template <class AL, class BL>
__device__ __forceinline__ void gemm256_kloop(f32x16 (&acc)[2][4], const AL& al, const BL& bl, int nk, unsigned char* lds0, int t512) {
    const int srow = t512 >> 3;
    const int csrc = ((t512 & 7) ^ ((srow >> 1) & 7)) * 8;
#define G2_ISSUE(BUF, KT) { const int k_ = (KT) * 64 + csrc; _Pragma("unroll") for (int i = 0; i < 4; ++i) { \
        __builtin_amdgcn_global_load_lds((const unsigned*)al(srow + 64 * i, k_), (unsigned*)(lds0 + (BUF) * ST2_B + i * 8192 + t512 * 16), 16, 0, 0); \
        __builtin_amdgcn_global_load_lds((const unsigned*)bl(srow + 64 * i, k_), (unsigned*)(lds0 + (BUF) * ST2_B + 32768 + i * 8192 + t512 * 16), 16, 0, 0); } }
    const int last = nk - 1;
    __syncthreads();
    G2_ISSUE(0, 0);
    __syncthreads();
#pragma unroll 1
    for (int kt = 0; kt < nk; kt += 2) {
        G2_ISSUE(1, (kt + 1));
        compute_ktile256(acc, lds0, lds0 + 32768, t512);
        __syncthreads();
        G2_ISSUE(0, (kt + 2 < last ? kt + 2 : last));
        compute_ktile256(acc, lds0 + ST2_B, lds0 + ST2_B + 32768, t512);
        __syncthreads();
    }
#undef G2_ISSUE
}

#define ROWU(mi, reg) (wm * 64 + (mi) * 32 + 8 * ((reg) >> 2) + ((reg) & 3))
__device__ __forceinline__ void zero_acc256(f32x16 (&acc)[2][4]) {
#pragma unroll
    for (int i = 0; i < 2; ++i)
#pragma unroll
        for (int j = 0; j < 4; ++j)
#pragma unroll
            for (int e = 0; e < 16; ++e) acc[i][j][e] = 0.f;
}
__device__ __forceinline__ bool tile256(int it, int NT, int ntiles, int& mt, int& nt) {
    const int G = gridDim.x, b = blockIdx.x;
    if ((G & 7) == 0) {
        const int s = it * (G >> 3) + (b >> 3);
        if (s >= (ntiles >> 3)) return false;
        mt = (s / NT) * 8 + (b & 7); nt = s % NT;
    } else {
        const int t = it * G + b;
        if (t >= ntiles) return false;
        mt = t / NT; nt = t % NT;
    }
    return true;
}
__device__ __forceinline__ bool tile256_in(int it, int NT, int& mt, int& nt) {
    const int G = gridDim.x, b = blockIdx.x;
    if ((G & 7) == 0) {
        const int NG = NT >> 2;
        const int s = it * (G >> 3) + (b >> 3);
        const int ml = s / NG;
        if (ml >= 192) return false;
        const int x = b & 7;
        mt = (x >> 2) * 192 + ml; nt = (x & 3) * NG + (s - ml * NG);
    } else {
        const int t = it * G + b;
        if (t >= 384 * NT) return false;
        mt = t / NT; nt = t % NT;
    }
    return true;
}

__device__ __forceinline__ void zero_acc(f32x16 (&acc)[2][2]) {
#pragma unroll
    for (int i = 0; i < 2; ++i)
#pragma unroll
        for (int j = 0; j < 2; ++j)
#pragma unroll
            for (int e = 0; e < 16; ++e) acc[i][j][e] = 0.f;
}

__device__ __forceinline__ void transpose_tile(const float* src, int K, int N, bf16_t* dst, int tile, unsigned char* lds, int wv) {
    float* tl = (float*)lds;
    const int ntn = N / 64;
    const int k0 = (tile / ntn) * 64, n0 = (tile % ntn) * 64;
    const int tid = tidx();
    __syncthreads();
#pragma unroll
    for (int i = 0; i < 4; ++i) {
        const int r = (tid >> 4) + 16 * i, c4 = (tid & 15) * 4;
        const float4 v = *(const float4*)(src + (size_t)(k0 + r) * N + n0 + c4);
        tl[r * 65 + c4 + 0] = v.x; tl[r * 65 + c4 + 1] = v.y; tl[r * 65 + c4 + 2] = v.z; tl[r * 65 + c4 + 3] = v.w;
    }
    __syncthreads();
#pragma unroll
    for (int i = 0; i < 2; ++i) {
        const int n = (tid >> 3) + 32 * i, k8 = (tid & 7) * 8;
        uint4 o;
        o.x = pk2(tl[(k8 + 0) * 65 + n], tl[(k8 + 1) * 65 + n]);
        o.y = pk2(tl[(k8 + 2) * 65 + n], tl[(k8 + 3) * 65 + n]);
        o.z = pk2(tl[(k8 + 4) * 65 + n], tl[(k8 + 5) * 65 + n]);
        o.w = pk2(tl[(k8 + 6) * 65 + n], tl[(k8 + 7) * 65 + n]);
        *(uint4*)(dst + (size_t)(n0 + n) * K + k0 + k8) = o;
    }
}

__device__ __forceinline__ void mod_tile(const Params& p, int tile, unsigned char* lds, int wv) {
    float* sc = (float*)lds;
    float* red = (float*)(lds + 49152);
    const int L = tile / 96, n0 = (tile % 96) * 32;
    const int tid = tidx();
    __syncthreads();
    for (int i = tid; i < 12 * 1024; i += 256) {
        const int b = i >> 10, k = i & 1023;
        sc[i] = siluf_(c_row(p, b)[k]);
    }
    __syncthreads();
    const int kg = tid >> 5, col = tid & 31;
    float a[12];
#pragma unroll
    for (int b = 0; b < 12; ++b) a[b] = 0.f;
    const float* w = p.w_mod + (size_t)L * 1024 * 3072 + n0 + col;
#pragma unroll 1
    for (int k0 = kg * 128; k0 < kg * 128 + 128; k0 += 8) {
        float wq[8];
#pragma unroll
        for (int u = 0; u < 8; ++u) wq[u] = w[(size_t)(k0 + u) * 3072];
#pragma unroll
        for (int u = 0; u < 8; ++u)
#pragma unroll
            for (int b = 0; b < 12; ++b) a[b] += sc[b * 1024 + k0 + u] * wq[u];
    }
#pragma unroll
    for (int b = 0; b < 12; ++b) red[(kg * 12 + b) * 32 + col] = a[b];
    __syncthreads();
    for (int i = tid; i < 12 * 32; i += 256) {
        const int b = i >> 5, c = i & 31;
        float s = 0.f;
#pragma unroll
        for (int g = 0; g < 8; ++g) s += red[(g * 12 + b) * 32 + c];
        float* mod = (float*)(p.ws + OFF_MOD);
        mod[((size_t)L * 12 + b) * 3072 + n0 + c] = s + p.b_mod[(size_t)L * 3072 + n0 + c];
    }
}

__device__ __forceinline__ void phase_prologue(const Params& p, unsigned char* lds, int hb, int wv) {
    bf16_t* W = (bf16_t*)(p.ws + OFF_W);
    const int NTR = 4736, NMOD = 384, NROT = 2048;
    for (int t = VB; t < NTR + NMOD + NROT; t += VG) {
        if (t < NTR) {
            const float* src; int K, N; bf16_t* dst; int tile;
            if (t < 1536)      { const int j = t / 768;          tile = t % 768;          src = p.w_in_ab + (size_t)j * 3145728; K = 1024; N = 3072; dst = W + W_IN_AB + (size_t)j * 3145728; }
            else if (t < 2048) { const int j = (t - 1536) / 256; tile = (t - 1536) % 256; src = p.w_out_ab + (size_t)j * 1048576; K = 1024; N = 1024; dst = W + W_OUT_AB + (size_t)j * 1048576; }
            else if (t < 2176) { const int j = (t - 2048) / 64;  tile = (t - 2048) % 64;  src = p.w_glu + (size_t)j * 262144; K = 512; N = 512; dst = W + W_GLU + (size_t)j * 262144; }
            else if (t < 4224) { const int j = (t - 2176) / 1024; tile = (t - 2176) % 1024; src = p.w_in_c + (size_t)j * 4194304; K = 1024; N = 4096; dst = W + W_IN_C + (size_t)j * 4194304; }
            else               { const int j = (t - 4224) / 256; tile = (t - 4224) % 256; src = p.w_out_c + (size_t)j * 1048576; K = 1024; N = 1024; dst = W + W_OUT_C + (size_t)j * 1048576; }
            transpose_tile(src, K, N, dst, tile, lds, wv);
        } else if (t < NTR + NMOD) {
            mod_tile(p, t - NTR, lds, wv);
        } else {
            const int idx = (t - NTR - NMOD) * 256 + tidx();
            const int pos = idx >> 6, i = idx & 63;
            const float inv = powf(10000.f, -(float)(2 * i) / 128.f);
            const float ang = (float)pos * inv;
            float s, c;
            sincosf(ang, &s, &c);
            ((float*)(p.ws + OFF_COS))[idx] = c;
            ((float*)(p.ws + OFF_SIN))[idx] = s;
        }
    }
}

__device__ __forceinline__ void phase_norm(const Params& p, int L, int hb, int wv) {
    const int tid = tidx();
    const int lane = tid & 63, wave = tid >> 6;
    bf16_t* B = (bf16_t*)(p.ws + OFF_B);
    const float* mod = (const float*)(p.ws + OFF_MOD);
#define XBF(r) ((bf16_t*)((unsigned char*)p.out + (size_t)(r) * 4096 + 2048))
    float4 xn[4];
    uint2 xbn[4] = {make_uint2(0u, 0u), make_uint2(0u, 0u), make_uint2(0u, 0u), make_uint2(0u, 0u)};
    uint2 yn[4];
    {
        const int row = VB * 4 + wave;
#pragma unroll
        for (int i = 0; i < 4; ++i) {
            if (L <= 1) xn[i] = *(const float4*)(x_row(p, row) + i * 256 + lane * 4);
            else { xbn[i] = *(const uint2*)(XBF(row) + i * 256 + lane * 4); xn[i] = make_float4(0.f, 0.f, 0.f, 0.f); }
            yn[i] = (L >= 1) ? *(const uint2*)(B + (size_t)row * DM + i * 256 + lane * 4) : make_uint2(0u, 0u);
        }
    }
    float4 g4a[4], n4a[4], sha[4], scla[4], npa[4];
#pragma unroll
    for (int i = 0; i < 4; ++i) {
        g4a[i] = n4a[i] = sha[i] = scla[i] = npa[i] = make_float4(0.f, 0.f, 0.f, 0.f);
        if (L >= 1) n4a[i] = *(const float4*)(p.norm_post + (size_t)(L - 1) * DM + i * 256 + lane * 4);
        if (L <= 3) npa[i] = *(const float4*)(p.norm_pre + (size_t)L * DM + i * 256 + lane * 4);
    }
    int bprev = -1;
    for (int t = VB; t < T_TOK / 4; t += VG) {
        const int row = t * 4 + wave;
        const int b = row / SEQL;
        if (b != bprev) {
            bprev = b;
#pragma unroll
            for (int i = 0; i < 4; ++i) {
                if (L >= 1) g4a[i] = *(const float4*)(mod + ((size_t)(L - 1) * 12 + b) * 3072 + 2048 + i * 256 + lane * 4);
                if (L <= 3) {
                    sha[i] = *(const float4*)(mod + ((size_t)L * 12 + b) * 3072 + i * 256 + lane * 4);
                    scla[i] = *(const float4*)(mod + ((size_t)L * 12 + b) * 3072 + 1024 + i * 256 + lane * 4);
                }
            }
        }
        float x[16], y[16];
#pragma unroll
        for (int i = 0; i < 4; ++i) {
            if (L <= 1) { x[4 * i] = xn[i].x; x[4 * i + 1] = xn[i].y; x[4 * i + 2] = xn[i].z; x[4 * i + 3] = xn[i].w; }
            else {
                x[4 * i] = __uint_as_float(xbn[i].x << 16); x[4 * i + 1] = __uint_as_float(xbn[i].x & 0xffff0000u);
                x[4 * i + 2] = __uint_as_float(xbn[i].y << 16); x[4 * i + 3] = __uint_as_float(xbn[i].y & 0xffff0000u);
            }
            y[4 * i] = __uint_as_float(yn[i].x << 16); y[4 * i + 1] = __uint_as_float(yn[i].x & 0xffff0000u);
            y[4 * i + 2] = __uint_as_float(yn[i].y << 16); y[4 * i + 3] = __uint_as_float(yn[i].y & 0xffff0000u);
        }
        {
            const int tn = (t + VG < T_TOK / 4) ? t + VG : t;
            const int rown = tn * 4 + wave;
#pragma unroll
            for (int i = 0; i < 4; ++i) {
                if (L <= 1) xn[i] = *(const float4*)(x_row(p, rown) + i * 256 + lane * 4);
                else xbn[i] = *(const uint2*)(XBF(rown) + i * 256 + lane * 4);
                if (L >= 1) yn[i] = *(const uint2*)(B + (size_t)rown * DM + i * 256 + lane * 4);
            }
        }
        if (L >= 1) {
            float ss = 0.f;
#pragma unroll
            for (int e = 0; e < 16; ++e) ss += y[e] * y[e];
#pragma unroll
            for (int o = 32; o >= 1; o >>= 1) ss += __shfl_xor(ss, o);
            const float ry = rsqrtf(ss * (1.f / 1024.f) + EPSF);
#pragma unroll
            for (int i = 0; i < 4; ++i) {
                const int c = i * 256 + lane * 4;
                const float4 g4 = g4a[i];
                const float4 n4 = n4a[i];
                x[4 * i + 0] += g4.x * (y[4 * i + 0] * ry * n4.x);
                x[4 * i + 1] += g4.y * (y[4 * i + 1] * ry * n4.y);
                x[4 * i + 2] += g4.z * (y[4 * i + 2] * ry * n4.z);
                x[4 * i + 3] += g4.w * (y[4 * i + 3] * ry * n4.w);
                if (L == 4) {
                    float4 o; o.x = x[4 * i]; o.y = x[4 * i + 1]; o.z = x[4 * i + 2]; o.w = x[4 * i + 3];
                    *(float4*)(p.out + (size_t)row * DM + c) = o;
                } else {
                    st4(XBF(row) + c, x[4 * i], x[4 * i + 1], x[4 * i + 2], x[4 * i + 3]);
                }
            }
        }
        if (L <= 3) {
            float ss = 0.f;
#pragma unroll
            for (int e = 0; e < 16; ++e) ss += x[e] * x[e];
#pragma unroll
            for (int o = 32; o >= 1; o >>= 1) ss += __shfl_xor(ss, o);
            const float rx = rsqrtf(ss * (1.f / 1024.f) + EPSF);
#pragma unroll
            for (int i = 0; i < 4; ++i) {
                const int c = i * 256 + lane * 4;
                const float4 sh = sha[i];
                const float4 scl = scla[i];
                const float4 n4 = npa[i];
                const float h0 = x[4 * i + 0] * rx * n4.x * (1.f + scl.x) + sh.x;
                const float h1 = x[4 * i + 1] * rx * n4.y * (1.f + scl.y) + sh.y;
                const float h2 = x[4 * i + 2] * rx * n4.z * (1.f + scl.z) + sh.z;
                const float h3 = x[4 * i + 3] * rx * n4.w * (1.f + scl.w) + sh.w;
                st4(B + (size_t)row * DM + c, h0, h1, h2, h3);
            }
        }
    }
}

__device__ __forceinline__ void phase_inproj_even(const Params& p, int j, unsigned char* lds0, int hb, int wv) {
    const bf16_t* H = (const bf16_t*)(p.ws + OFF_B);
    const bf16_t* Wt = (const bf16_t*)(p.ws + OFF_W) + W_IN_AB + (size_t)j * 3145728;
    bf16_t* Z = (bf16_t*)(p.ws + OFF_Z);
    bf16_t* VT = (bf16_t*)(p.ws + OFF_Z + ZE_VT);
    bf16_t* KT = (bf16_t*)(p.ws + OFF_Z + ZE_KT);
    const float* COS = (const float*)(p.ws + OFF_COS);
    const float* SIN = (const float*)(p.ws + OFF_SIN);
    const int t512 = t512x();
    for (int it = 0;; ++it) {
        int mt, nt;
        if (!tile256_in(it, 12, mt, nt)) break;
        const int m0 = mt * 256, n0 = nt * 256;
        const bf16_t* Hm = H + (size_t)m0 * 1024;
        const bf16_t* Wn = Wt + (size_t)n0 * 1024;
        auto al = [&](int r, int k) { return Hm + (unsigned)(r * 1024 + k); };
        auto bl = [&](int r, int k) { return Wn + (unsigned)(r * 1024 + k); };
        f32x16 acc[2][4];
        zero_acc256(acc);
        gemm256_kloop(acc, al, bl, 16, lds0, t512);
        int tq = t512;
        asm volatile("" : "+v"(tq));
        const int lane = tq & 63, wave = tq >> 6, wm = wave >> 1, wn = wave & 1, l31 = lane & 31, half = lane >> 5;
        const int cw = n0 + wn * 128;
        const int seg = cw >> 9;
        const int bb = m0 / SEQL;
        const int rbase = m0 + wm * 64 + 4 * half;
        if (seg == 2) {
#pragma unroll
            for (int mi = 0; mi < 2; ++mi)
#pragma unroll
                for (int nj = 0; nj < 4; ++nj) {
                    const int n = cw - 1024 + nj * 32 + l31;
#pragma unroll
                    for (int q4 = 0; q4 < 4; ++q4) {
                        const int pos = (rbase % SEQL) + mi * 32 + 8 * q4;
                        st4(VT + ((size_t)bb * 512 + n) * SEQL + pos, acc[mi][nj][4 * q4], acc[mi][nj][4 * q4 + 1], acc[mi][nj][4 * q4 + 2], acc[mi][nj][4 * q4 + 3]);
                    }
                }
        } else if (seg <= 1) {
            const float ksc = (seg == 1) ? 0.08838834764831845f : 1.f;
            const int hd = (cw & 511) >> 7;
#pragma unroll
            for (int mi = 0; mi < 2; ++mi)
#pragma unroll
                for (int nj = 0; nj < 2; ++nj) {
                    const int d = nj * 32 + l31;
#pragma unroll
                    for (int hq = 0; hq < 2; ++hq) {
                        float cc8[8], sn8[8];
#pragma unroll
                        for (int r8 = 0; r8 < 8; ++r8) {
                            const int pos = (rbase + mi * 32 + 8 * (hq * 2 + (r8 >> 2)) + (r8 & 3)) % SEQL;
                            cc8[r8] = COS[pos * 64 + d]; sn8[r8] = SIN[pos * 64 + d];
                        }
#pragma unroll
                        for (int qq = 0; qq < 2; ++qq) {
                            const int q4 = hq * 2 + qq;
                            float o1[4], o2[4];
                            const int row0 = rbase + mi * 32 + 8 * q4;
#pragma unroll
                            for (int r = 0; r < 4; ++r) {
                                const int row = row0 + r;
                                const float cc = cc8[qq * 4 + r], sn = sn8[qq * 4 + r];
                                const float x1 = acc[mi][nj][4 * q4 + r], x2 = acc[mi][nj + 2][4 * q4 + r];
                                o1[r] = (x1 * cc - x2 * sn) * ksc;
                                o2[r] = (x1 * sn + x2 * cc) * ksc;
                                Z[(size_t)row * ZE_LD + cw + d] = f2bf(o1[r]);
                                Z[(size_t)row * ZE_LD + cw + 64 + d] = f2bf(o2[r]);
                            }
                            if (seg == 1) {
                                bf16_t* kt = KT + ((size_t)(bb * 4 + hd) * 128) * SEQL + (row0 % SEQL);
                                st4(kt + (size_t)d * SEQL, o1[0], o1[1], o1[2], o1[3]);
                                st4(kt + (size_t)(64 + d) * SEQL, o2[0], o2[1], o2[2], o2[3]);
                            }
                        }
                    }
                }
        } else if (seg == 4) {
            bf16_t* US = (bf16_t*)(p.ws + OFF_Z + ZE_US);
#pragma unroll
            for (int mi = 0; mi < 2; ++mi)
#pragma unroll
                for (int nj = 0; nj < 4; ++nj) {
                    const int n = cw - 2048 + nj * 32 + l31;
                    const int g = n >> 4, i = n & 15;
#pragma unroll
                    for (int reg = 0; reg < 16; ++reg) {
                        const int row = rbase + mi * 32 + 8 * (reg >> 2) + (reg & 3);
                        US[(((size_t)(row >> 6) * 32 + g) * 64 + (row & 63)) * 16 + i] = f2bf(acc[mi][nj][reg]);
                    }
                }
        } else {
            const int cb = (seg == 3) ? cw - 512 : cw - 1024;
#pragma unroll
            for (int mi = 0; mi < 2; ++mi)
#pragma unroll
                for (int nj = 0; nj < 4; ++nj) {
                    const int col = cb + nj * 32 + l31;
#pragma unroll
                    for (int reg = 0; reg < 16; ++reg) {
                        const int row = rbase + mi * 32 + 8 * (reg >> 2) + (reg & 3);
                        Z[(size_t)row * ZE_LD + col] = f2bf(acc[mi][nj][reg]);
                    }
                }
        }
    }
}

__device__ __forceinline__ void phase_inproj_odd(const Params& p, int j, unsigned char* lds0, int hb, int wv) {
    const bf16_t* H = (const bf16_t*)(p.ws + OFF_B);
    const bf16_t* Wt = (const bf16_t*)(p.ws + OFF_W) + W_IN_C + (size_t)j * 4194304;
    bf16_t* Z = (bf16_t*)(p.ws + OFF_Z);
    bf16_t* VT = (bf16_t*)(p.ws + OFF_Z + ZO_VT);
    const int t512 = t512x();
    for (int it = 0;; ++it) {
        int mt, nt;
        if (!tile256_in(it, 16, mt, nt)) break;
        const int m0 = mt * 256, n0 = nt * 256;
        const bf16_t* Hm = H + (size_t)m0 * 1024;
        const bf16_t* Wn = Wt + (size_t)n0 * 1024;
        auto al = [&](int r, int k) { return Hm + (unsigned)(r * 1024 + k); };
        auto bl = [&](int r, int k) { return Wn + (unsigned)(r * 1024 + k); };
        f32x16 acc[2][4];
        zero_acc256(acc);
        gemm256_kloop(acc, al, bl, 16, lds0, t512);
        int tq = t512;
        asm volatile("" : "+v"(tq));
        const int lane = tq & 63, wm = wv >> 1, wn = wv & 1, l31 = lane & 31, half = lane >> 5;
        const int cw = n0 + wn * 128;
        const int seg = cw >> 10;
        if (seg == 2) {
            const int bb = m0 / SEQL, p0 = m0 % SEQL;
            const unsigned lo = (unsigned)(l31 * SEQL + 4 * half);
#pragma unroll
            for (int mi = 0; mi < 2; ++mi)
#pragma unroll
                for (int nj = 0; nj < 4; ++nj) {
                    bf16_t* vb = VT + ((size_t)bb * 1024 + (cw - 2048 + nj * 32)) * SEQL + p0 + wm * 64 + mi * 32;
#pragma unroll
                    for (int q4 = 0; q4 < 4; ++q4)
                        st4(vb + 8 * q4 + lo, acc[mi][nj][4 * q4], acc[mi][nj][4 * q4 + 1], acc[mi][nj][4 * q4 + 2], acc[mi][nj][4 * q4 + 3]);
                }
        } else {
            const float sc = (seg == 0) ? 0.125f : 1.f;
            const int cbase = (seg == 3) ? cw - 1024 : cw;
            const unsigned lo = (unsigned)(4 * half * ZO_LD + l31);
#pragma unroll
            for (int mi = 0; mi < 2; ++mi)
#pragma unroll
                for (int nj = 0; nj < 4; ++nj)
#pragma unroll
                    for (int reg = 0; reg < 16; ++reg) {
                        bf16_t* zb = Z + (size_t)(m0 + ROWU(mi, reg)) * ZO_LD + cbase + nj * 32;
                        zb[lo] = f2bf(acc[mi][nj][reg] * sc);
                    }
        }
    }
}

__device__ __forceinline__ void phase_outproj(const Params& p, int L, unsigned char* lds0, int hb, int wv) {
    const int j = L >> 1;
    const bool even = (L & 1) == 0;
    const bf16_t* Z = (const bf16_t*)(p.ws + OFF_Z);
    const bf16_t* Wt = (const bf16_t*)(p.ws + OFF_W) + (even ? W_OUT_AB : W_OUT_C) + (size_t)j * 1048576;
    bf16_t* Y = (bf16_t*)(p.ws + OFF_B);
    const bf16_t* OBp = (const bf16_t*)(p.ws + OFF_Z + ZE_US);
    const int ld = even ? ZE_LD : ZO_LD;
    const int t512 = t512x();
    for (int it = 0;; ++it) {
        int mt, nt;
        if (!tile256(it, 4, 384 * 4, mt, nt)) break;
        const int m0 = mt * 256, n0 = nt * 256;
        const bf16_t* OBm = OBp + (size_t)m0 * 512;
        const bf16_t* Zm = Z + (size_t)m0 * ld;
        const bf16_t* Wn = Wt + (size_t)n0 * 1024;
        auto al = [&](int r, int k) {
            if (even && k >= 512) return OBm + (unsigned)(r * 512 + (k - 512));
            return Zm + (unsigned)(r * ld + k);
        };
        auto bl = [&](int r, int k) { return Wn + (unsigned)(r * 1024 + k); };
        f32x16 acc[2][4];
        zero_acc256(acc);
        gemm256_kloop(acc, al, bl, 16, lds0, t512);
        int tq = t512;
        asm volatile("" : "+v"(tq));
        const int lane = tq & 63, wm = wv >> 1, wn = wv & 1, l31 = lane & 31, half = lane >> 5;
        {
            const unsigned lo = (unsigned)(4 * half * 1024 + l31);
#pragma unroll
            for (int mi = 0; mi < 2; ++mi)
#pragma unroll
                for (int nj = 0; nj < 4; ++nj)
#pragma unroll
                    for (int reg = 0; reg < 16; ++reg) {
                        bf16_t* yb = Y + (size_t)(m0 + ROWU(mi, reg)) * 1024 + n0 + wn * 128 + nj * 32;
                        yb[lo] = f2bf(acc[mi][nj][reg]);
                    }
        }
    }
}

__device__ __forceinline__ void cpow(float zre, float zim, float k, float& pr, float& pi) {
    const float mag = expf(k * zre);
    float s, c;
    sincosf(k * zim, &s, &c);
    pr = mag * c; pi = mag * s;
}

__device__ __forceinline__ void phase_s5consts(const Params& p, int j, unsigned char* lds, int hb, int wv) {
    bf16_t* KMAT = (bf16_t*)(p.ws + OFF_B + B_KMAT);
    bf16_t* EMAT = (bf16_t*)(p.ws + OFF_B + B_EMAT);
    float* sz = (float*)lds;
    float* sg = (float*)(lds + 4096);
    const int tid = tidx();
    const int NA_ = 32 * 8, NB_ = 32 * 8, NC_ = 32 * 8;
    for (int t = VB; t < NA_ + NB_ + NC_; t += VG) {
        int g, sub, type;
        if (t < NA_) { type = 0; g = t >> 3; sub = t & 7; }
        else if (t < NA_ + NB_) { type = 1; g = (t - NA_) >> 3; sub = (t - NA_) & 7; }
        else { type = 2; g = (t - NA_ - NB_) >> 3; sub = (t - NA_ - NB_) & 7; }
        __syncthreads();
        if (tid < 128) {
            const int dir = tid >> 6, pp = tid & 63;
            const size_t base = ((size_t)(j * 2 + dir) * 32 + g);
            const float delta = expf(p.log_step[base]);
            const float are = p.a_re[base * 64 + pp], aim = p.a_im[base * 64 + pp];
            const float zre = are * delta, zim = aim * delta;
            float abr, abi;
            cpow(zre, zim, 1.f, abr, abi);
            const float den = are * are + aim * aim;
            const float nre = abr - 1.f, nim = abi;
            sz[tid * 4 + 0] = zre; sz[tid * 4 + 1] = zim;
            sz[tid * 4 + 2] = (nre * are + nim * aim) / den;
            sz[tid * 4 + 3] = (nim * are - nre * aim) / den;
        }
        __syncthreads();
        if (type == 0) {
            const int tau0 = sub * 8;
            bf16_t* Kt = (bf16_t*)(lds + 16384);
            const int o = tid >> 4, i = tid & 15;
#pragma unroll 1
            for (int dir = 0; dir < 2; ++dir) {
                const int kmax = dir == 0 ? tau0 + 7 : 63 - tau0;
                const size_t base = ((size_t)(j * 2 + dir) * 32 + g);
                float* scb = (float*)(lds + 53248);
                __syncthreads();
                for (int e = tid; e < 1024; e += 256) {
                    scb[e] = p.c_re[base * 1024 + e];
                    scb[1024 + e] = p.c_im[base * 1024 + e];
                    scb[2048 + e] = p.b_re[base * 1024 + e];
                    scb[3072 + e] = p.b_im[base * 1024 + e];
                }
                const float* cre = scb + o * 64;
                const float* cim = scb + 1024 + o * 64;
                const float* bre = scb + 2048 + i;
                const float* bim = scb + 3072 + i;
#pragma unroll 1
                for (int k0 = 0; k0 <= kmax; k0 += 16) {
                    __syncthreads();
                    for (int e = tid; e < 16 * 64; e += 256) {
                        const int dd = e >> 6, pp = e & 63;
                        float pr, pi;
                        cpow(sz[(dir * 64 + pp) * 4], sz[(dir * 64 + pp) * 4 + 1], (float)(k0 + dd), pr, pi);
                        const float fr = sz[(dir * 64 + pp) * 4 + 2], fi = sz[(dir * 64 + pp) * 4 + 3];
                        sg[e * 2] = pr * fr - pi * fi;
                        sg[e * 2 + 1] = pr * fi + pi * fr;
                    }
                    __syncthreads();
                    float acc[16];
#pragma unroll
                    for (int dd = 0; dd < 16; ++dd) acc[dd] = 0.f;
                    for (int pp = 0; pp < 64; ++pp) {
                        const float cr = cre[pp], ci = cim[pp], br = bre[pp * 16], bi = bim[pp * 16];
                        const float wr = cr * br - ci * bi, wi = cr * bi + ci * br;
#pragma unroll
                        for (int dd = 0; dd < 16; ++dd) { const float2 gg = *(const float2*)(sg + (dd * 64 + pp) * 2); acc[dd] += gg.x * wr - gg.y * wi; }
                    }
#pragma unroll
                    for (int dd = 0; dd < 16; ++dd) {
                        const int k = k0 + dd;
                        if (k <= kmax) {
                            const int didx = (dir == 0 ? k : -k) - (tau0 - 63);
                            float v = acc[dd];
                            if (dir == 1 && k == 0) v += bf2f(Kt[didx * 256 + tid]);
                            Kt[didx * 256 + tid] = f2bf(v);
                        }
                    }
                }
            }
            __syncthreads();
            bf16_t* km = KMAT + (size_t)g * 1024 * 1280;
            for (int v = tid; v < 128 * 128; v += 256) {
                const int rowl = v >> 7, vv = v & 127;
                const int tau = tau0 + (rowl >> 4), oo = rowl & 15, s = vv >> 1, ih = vv & 1;
                const int didx = tau - s - (tau0 - 63);
                const uint4 val = *(const uint4*)(Kt + didx * 256 + oo * 16 + ih * 8);
                *(uint4*)(km + (size_t)(tau * 16 + oo) * 1280 + s * 16 + ih * 8) = val;
            }
        } else if (type == 1) {
            const int dir = tid >> 7, ri = (tid >> 6) & 1, pp = tid & 63;
            const size_t base = ((size_t)(j * 2 + dir) * 32 + g);
            bf16_t* km = KMAT + (size_t)g * 1024 * 1280;
            float cra[16], cia[16];
#pragma unroll
            for (int o = 0; o < 16; ++o) { cra[o] = p.c_re[(base * 16 + o) * 64 + pp]; cia[o] = p.c_im[(base * 16 + o) * 64 + pp]; }
#pragma unroll 1
            for (int u = 0; u < 8; ++u) {
                const int tau = sub * 8 + u;
                float pr, pi;
                const float kk = dir == 0 ? (float)(tau + 1) : (float)(64 - tau);
                cpow(sz[(dir * 64 + pp) * 4], sz[(dir * 64 + pp) * 4 + 1], kk, pr, pi);
#pragma unroll
                for (int o = 0; o < 16; ++o) {
                    const float cr = cra[o], ci = cia[o];
                    const float wr = cr * pr - ci * pi, wi = cr * pi + ci * pr;
                    km[(size_t)(tau * 16 + o) * 1280 + 1024 + tid] = f2bf(ri == 0 ? wr : -wi);
                }
            }
        } else {
            const int dir = tid >> 7, ri = (tid >> 6) & 1, pp = tid & 63;
            const float fr = sz[(dir * 64 + pp) * 4 + 2], fi = sz[(dir * 64 + pp) * 4 + 3];
            const size_t base = ((size_t)(j * 2 + dir) * 32 + g);
            const float* bre = p.b_re + (base * 64 + pp) * 16;
            const float* bim = p.b_im + (base * 64 + pp) * 16;
            float bra[16], bia[16];
#pragma unroll
            for (int i = 0; i < 16; ++i) { bra[i] = bre[i]; bia[i] = bim[i]; }
#pragma unroll 1
            for (int u = 0; u < 8; ++u) {
                const int s = sub * 8 + u;
                float pr, pi;
                const float kk = dir == 0 ? (float)(63 - s) : (float)s;
                cpow(sz[(dir * 64 + pp) * 4], sz[(dir * 64 + pp) * 4 + 1], kk, pr, pi);
                const float gr = pr * fr - pi * fi, gi = pr * fi + pi * fr;
                float v[16];
#pragma unroll
                for (int i = 0; i < 16; ++i) {
                    const float br = bra[i], bi = bia[i];
                    v[i] = ri == 0 ? (gr * br - gi * bi) : (gr * bi + gi * br);
                }
                uint4 o0, o1;
                o0.x = pk2(v[0], v[1]); o0.y = pk2(v[2], v[3]); o0.z = pk2(v[4], v[5]); o0.w = pk2(v[6], v[7]);
                o1.x = pk2(v[8], v[9]); o1.y = pk2(v[10], v[11]); o1.z = pk2(v[12], v[13]); o1.w = pk2(v[14], v[15]);
                bf16_t* em = EMAT + ((size_t)g * 256 + tid) * 1024 + s * 16;
                *(uint4*)em = o0;
                *(uint4*)(em + 8) = o1;
            }
        }
    }
}

__device__ __forceinline__ void phase_s5A(const Params& p, unsigned char* lds0, int hb, int wv) {
    const bf16_t* US = (const bf16_t*)(p.ws + OFF_Z + ZE_US);
    const bf16_t* EMAT = (const bf16_t*)(p.ws + OFF_B + B_EMAT);
    float* E = (float*)(p.ws + OFF_Z + ZE_E);
    const int t512 = t512x();
    for (int t = blockIdx.x; t < 32 * 6; t += gridDim.x) {
        const int g = t / 6, mt = t % 6, m0 = mt * 256;
        const bf16_t* USg = US + ((size_t)m0 * 32 + g) * 1024;
        const bf16_t* EMg = EMAT + (size_t)g * 256 * 1024;
        auto al = [&](int r, int k) { return USg + (unsigned)(r * 32768 + k); };
        auto bl = [&](int r, int k) { return EMg + (unsigned)(r * 1024 + k); };
        f32x16 acc[2][4];
        zero_acc256(acc);
        gemm256_kloop(acc, al, bl, 16, lds0, t512);
        int tq = t512;
        asm volatile("" : "+v"(tq));
        const int lane = tq & 63, wm = wv >> 1, wn = wv & 1, l31 = lane & 31, half = lane >> 5;
        const unsigned lo = (unsigned)(4 * half * 8192 + l31);
#pragma unroll
        for (int mi = 0; mi < 2; ++mi)
#pragma unroll
            for (int nj = 0; nj < 4; ++nj)
#pragma unroll
                for (int reg = 0; reg < 16; ++reg) {
                    float* eb = E + ((size_t)(m0 + ROWU(mi, reg)) * 32 + g) * 256 + wn * 128 + nj * 32;
                    eb[lo] = acc[mi][nj][reg];
                }
    }
}

__device__ __forceinline__ void phase_s5scan(const Params& p, int j, int hb, int wv) {
    const float* E = (const float*)(p.ws + OFF_Z + ZE_E);
    bf16_t* CARRY = (bf16_t*)(p.ws + OFF_Z + ZE_CARRY);
    for (int it = VB * 256 + tidx(); it < 12 * 32 * 2 * 64; it += VG * 256) {
        const int pp = it & 63, dir = (it >> 6) & 1, g = (it >> 7) & 31, b = it >> 12;
        const size_t base = ((size_t)(j * 2 + dir) * 32 + g);
        const float delta = expf(p.log_step[base]);
        const float zre = p.a_re[base * 64 + pp] * delta, zim = p.a_im[base * 64 + pp] * delta;
        float ar, ai;
        cpow(zre, zim, 64.f, ar, ai);
        float fr = 0.f, fi = 0.f;
#pragma unroll 1
        for (int s0 = 0; s0 < 128; s0 += 32) {
            float er[32], ei[32];
#pragma unroll
            for (int u = 0; u < 32; ++u) {
                const int n = dir == 0 ? (s0 + u) : 127 - (s0 + u);
                const size_t idx = ((size_t)(b * 128 + n) * 32 + g) * 256 + dir * 128 + pp;
                er[u] = E[idx]; ei[u] = E[idx + 64];
            }
#pragma unroll
            for (int u = 0; u < 32; ++u) {
                const int n = dir == 0 ? (s0 + u) : 127 - (s0 + u);
                const size_t idx = ((size_t)(b * 128 + n) * 32 + g) * 256 + dir * 128 + pp;
                CARRY[idx] = f2bf(fr);
                CARRY[idx + 64] = f2bf(fi);
                const float nr = ar * fr - ai * fi + er[u];
                const float ni = ar * fi + ai * fr + ei[u];
                fr = nr; fi = ni;
            }
        }
    }
}

__device__ __forceinline__ void phase_s5main(const Params& p, int j, unsigned char* lds0, int hb, int wv) {
    const bf16_t* US = (const bf16_t*)(p.ws + OFF_Z + ZE_US);
    const bf16_t* KMAT = (const bf16_t*)(p.ws + OFF_B + B_KMAT);
    const bf16_t* CARRY = (const bf16_t*)(p.ws + OFF_Z + ZE_CARRY);
    bf16_t* YG = (bf16_t*)(p.ws + OFF_B + B_YG);
    const int t512 = t512x();
    for (int it = 0;; ++it) {
        int t;
        if (gridDim.x == 256) { if (it >= 3) break; const int s = it * 32 + (int)(blockIdx.x >> 3); t = ((int)(blockIdx.x & 7) * 4 + s / 24) * 24 + s % 24; }
        else { t = it * (int)gridDim.x + (int)blockIdx.x; if (t >= 32 * 6 * 4) break; }
        const int g = t / 24, mt = (t % 24) >> 2, nt = t & 3, m0 = mt * 256, n0 = nt * 256;
        const bf16_t* USg = US + ((size_t)m0 * 32 + g) * 1024;
        const bf16_t* CAg = CARRY + ((size_t)m0 * 32 + g) * 256;
        const bf16_t* KMg = KMAT + ((size_t)g * 1024 + n0) * 1280;
        auto al = [&](int r, int k) {
            if (k < 1024) return USg + (unsigned)(r * 32768 + k);
            return CAg + (unsigned)(r * 8192 + (k - 1024));
        };
        auto bl = [&](int r, int k) { return KMg + (unsigned)(r * 1280 + k); };
        f32x16 acc[2][4];
        zero_acc256(acc);
        gemm256_kloop(acc, al, bl, 20, lds0, t512);
        int tq = t512;
        asm volatile("" : "+v"(tq));
        const int lane = tq & 63, wm = wv >> 1, wn = wv & 1, l31 = lane & 31, half = lane >> 5;
        {
            const unsigned loU = (unsigned)(4 * half * 32768 + l31);
            const unsigned loY = (unsigned)(4 * half * 32768 + (l31 >> 4) * 512 + (l31 & 15));
            const float dsk = p.ssm_d[(size_t)j * 512 + g * 16 + (l31 & 15)];
            bf16_t uv[2][8];
#define S5_LOAD(Q, BUF) { const int mi_ = (Q) >> 3, nj_ = ((Q) >> 1) & 3, hq_ = (Q) & 1; const int nb_ = n0 + wn * 128 + nj_ * 32; \
            _Pragma("unroll") for (int r8 = 0; r8 < 8; ++r8) { const int reg = hq_ * 8 + r8; \
                uv[BUF][r8] = (US + ((size_t)(m0 + ROWU(mi_, reg)) * 32 + g) * 1024 + nb_)[loU]; } }
            S5_LOAD(0, 0);
#pragma unroll
            for (int q = 0; q < 16; ++q) {
                if (q + 1 < 16) S5_LOAD(q + 1, (q + 1) & 1);
                const int mi = q >> 3, nj = (q >> 1) & 3, hq = q & 1;
                const int nb = n0 + wn * 128 + nj * 32;
#pragma unroll
                for (int r8 = 0; r8 < 8; ++r8) {
                    const int reg = hq * 8 + r8;
                    bf16_t* yb = YG + ((size_t)(m0 + ROWU(mi, reg)) * 64 + (nb >> 4)) * 512 + g * 16;
                    yb[loY] = f2bf(gelu_tanh(acc[mi][nj][reg] + dsk * bf2f(uv[q & 1][r8])));
                }
            }
#undef S5_LOAD
        }
    }
}

__device__ __forceinline__ void phase_glu(const Params& p, int j, unsigned char* lds0, int hb, int wv) {
    const bf16_t* Z = (const bf16_t*)(p.ws + OFF_Z);
    bf16_t* OBp = (bf16_t*)(p.ws + OFF_Z + ZE_US);
    const bf16_t* YG = (const bf16_t*)(p.ws + OFF_B + B_YG);
    const bf16_t* Wt = (const bf16_t*)(p.ws + OFF_W) + W_GLU + (size_t)j * 262144;
    const int t512 = t512x();
    for (int t = blockIdx.x; t < 384 * 2; t += gridDim.x) {
        const int mt = t >> 1, nt = t & 1, m0 = mt * 256, n0 = nt * 256;
        const bf16_t* YGm = YG + (size_t)m0 * 512;
        const bf16_t* Wn = Wt + (size_t)n0 * 512;
        auto al = [&](int r, int k) { return YGm + (unsigned)(r * 512 + k); };
        auto bl = [&](int r, int k) { return Wn + (unsigned)(r * 512 + k); };
        f32x16 acc[2][4];
        zero_acc256(acc);
        gemm256_kloop(acc, al, bl, 8, lds0, t512);
        int tq = t512;
        asm volatile("" : "+v"(tq));
        const int lane = tq & 63, wm = wv >> 1, wn = wv & 1, l31 = lane & 31, half = lane >> 5;
        {
            const unsigned loY = (unsigned)(4 * half * 512 + l31), loZ = (unsigned)(4 * half * ZE_LD + l31);
            bf16_t yv[2][8], gv[2][8];
#define GLU_LOAD(Q, BUF) { const int mi_ = (Q) >> 3, nj_ = ((Q) >> 1) & 3, hq_ = (Q) & 1; const int cb_ = n0 + wn * 128 + nj_ * 32; \
            _Pragma("unroll") for (int r8 = 0; r8 < 8; ++r8) { const int reg = hq_ * 8 + r8; \
                yv[BUF][r8] = (YG + (size_t)(m0 + ROWU(mi_, reg)) * 512 + cb_)[loY]; \
                gv[BUF][r8] = (Z + (size_t)(m0 + ROWU(mi_, reg)) * ZE_LD + 1536 + cb_)[loZ]; } }
            GLU_LOAD(0, 0);
#pragma unroll
            for (int q = 0; q < 16; ++q) {
                if (q + 1 < 16) GLU_LOAD(q + 1, (q + 1) & 1);
                const int mi = q >> 3, nj = (q >> 1) & 3, hq = q & 1;
                const int cb = n0 + wn * 128 + nj * 32;
#pragma unroll
                for (int r8 = 0; r8 < 8; ++r8) {
                    const int reg = hq * 8 + r8;
                    (OBp + (size_t)(m0 + ROWU(mi, reg)) * 512 + cb)[loY] = f2bf(bf2f(yv[q & 1][r8]) * sigmoidf_(acc[mi][nj][reg]) * siluf_(bf2f(gv[q & 1][r8])));
                }
            }
#undef GLU_LOAD
        }
    }
}

__device__ __forceinline__ void phase_ret1(const Params& p, unsigned char* lds, int hb, int wv) {
    const bf16_t* VT = (const bf16_t*)(p.ws + OFF_Z + ZE_VT);
    const bf16_t* KT = (const bf16_t*)(p.ws + OFF_Z + ZE_KT);
    bf16_t* ST = (bf16_t*)(p.ws + OFF_B);
    const int tid = tidx();
    const int lane = tid & 63, wave = tid >> 6, wm = wave >> 1, wn = wave & 1, l31 = lane & 31, half = lane >> 5;
    for (int t = VB; t < 2 * 3072; t += VG) {
        const int dir = t / 3072, r3 = t % 3072, b = r3 / 256, n = (r3 >> 2) & 63, h = r3 & 3;
        const float l2g = log2_gamma(h);
        const bf16_t* vt = VT + ((size_t)(b * 4 + h) * 128) * SEQL + n * 128;
        const bf16_t* kt = KT + ((size_t)(b * 4 + h) * 128) * SEQL + n * 128;
        auto al = [&](int r, int k) {
            const uint4 v = *(const uint4*)(vt + (size_t)r * SEQL + k);
            float w[8];
#pragma unroll
            for (int e = 0; e < 8; ++e) w[e] = __builtin_amdgcn_exp2f(l2g * (dir == 0 ? (float)(128 - (k + e)) : (float)(k + e + 1)));
            uint4 o;
            o.x = pk2(__uint_as_float(v.x << 16) * w[0], __uint_as_float(v.x & 0xffff0000u) * w[1]);
            o.y = pk2(__uint_as_float(v.y << 16) * w[2], __uint_as_float(v.y & 0xffff0000u) * w[3]);
            o.z = pk2(__uint_as_float(v.z << 16) * w[4], __uint_as_float(v.z & 0xffff0000u) * w[5]);
            o.w = pk2(__uint_as_float(v.w << 16) * w[6], __uint_as_float(v.w & 0xffff0000u) * w[7]);
            return o;
        };
        auto bl = [&](int r, int k) { return *(const uint4*)(kt + (size_t)r * SEQL + k); };
        f32x16 acc[2][2];
        zero_acc(acc);
        gemm_kloop(acc, al, bl, 2, lds, tid);
        bf16_t* st = ST + ((((size_t)dir * 12 + b) * 64 + n) * 4 + h) * 16384;
#pragma unroll
        for (int mi = 0; mi < 2; ++mi) {
            const int e = wm * 64 + mi * 32 + l31;
#pragma unroll
            for (int nj = 0; nj < 2; ++nj)
#pragma unroll
                for (int q4 = 0; q4 < 4; ++q4) {
                    const int d = wn * 32 + nj * 64 + 8 * q4 + 4 * half;
                    st4(st + e * 128 + d, acc[mi][nj][4 * q4], acc[mi][nj][4 * q4 + 1], acc[mi][nj][4 * q4 + 2], acc[mi][nj][4 * q4 + 3]);
                }
        }
    }
}

__device__ __forceinline__ void phase_ret2(const Params& p, int hb, int wv) {
    bf16_t* ST = (bf16_t*)(p.ws + OFF_B);
    for (int it = VB * 256 + tidx(); it < 2 * 12 * 4 * 2048; it += VG * 256) {
        const int v = it & 2047, h = (it >> 11) & 3, bd = it >> 13;
        const int dir = bd / 12;
        const float dec = exp2f(128.f * log2_gamma(h));
        float c[8];
#pragma unroll
        for (int e = 0; e < 8; ++e) c[e] = 0.f;
#pragma unroll 1
        for (int s0 = 0; s0 < 64; s0 += 16) {
            uint4 kvv[16];
#pragma unroll
            for (int u = 0; u < 16; ++u) {
                const int n = dir == 0 ? (s0 + u) : 63 - (s0 + u);
                kvv[u] = *(const uint4*)(ST + (((size_t)bd * 64 + n) * 4 + h) * 16384 + v * 8);
            }
#pragma unroll
            for (int u = 0; u < 16; ++u) {
                const int n = dir == 0 ? (s0 + u) : 63 - (s0 + u);
                bf16_t* ptr = ST + (((size_t)bd * 64 + n) * 4 + h) * 16384 + v * 8;
                const uint4 kv = kvv[u];
                uint4 o;
                o.x = pk2(c[0], c[1]); o.y = pk2(c[2], c[3]); o.z = pk2(c[4], c[5]); o.w = pk2(c[6], c[7]);
                *(uint4*)ptr = o;
                c[0] = dec * c[0] + __uint_as_float(kv.x << 16); c[1] = dec * c[1] + __uint_as_float(kv.x & 0xffff0000u);
                c[2] = dec * c[2] + __uint_as_float(kv.y << 16); c[3] = dec * c[3] + __uint_as_float(kv.y & 0xffff0000u);
                c[4] = dec * c[4] + __uint_as_float(kv.z << 16); c[5] = dec * c[5] + __uint_as_float(kv.z & 0xffff0000u);
                c[6] = dec * c[6] + __uint_as_float(kv.w << 16); c[7] = dec * c[7] + __uint_as_float(kv.w & 0xffff0000u);
            }
        }
    }
}

__device__ __forceinline__ void phase_ret3(const Params& p, unsigned char* lds, int hb, int wv) {
    bf16_t* Z = (bf16_t*)(p.ws + OFF_Z);
    const bf16_t* VT = (const bf16_t*)(p.ws + OFF_Z + ZE_VT);
    const bf16_t* ST = (const bf16_t*)(p.ws + OFF_B);
    float2* stat = (float2*)(lds + 4 * STAGE_B);
    const int tid = tidx();
    const int lane = tid & 63, wave = tid >> 6, wm = wave >> 1, wn = wave & 1, l31 = lane & 31, half = lane >> 5;
    for (int t = VB; t < 3072; t += VG) {
        const int b = t / 256, n = (t >> 2) & 63, h = t & 3;
        const float l2g = log2_gamma(h);
        const size_t m0 = (size_t)b * SEQL + n * 128;
        const bf16_t* zq = Z + m0 * ZE_LD + h * 128;
        const bf16_t* zk = Z + m0 * ZE_LD + 512 + h * 128;
        const bf16_t* stf = ST + ((((size_t)0 * 12 + b) * 64 + n) * 4 + h) * 16384;
        const bf16_t* stb = ST + ((((size_t)1 * 12 + b) * 64 + n) * 4 + h) * 16384;
        const bf16_t* vt = VT + ((size_t)(b * 4 + h) * 128) * SEQL + n * 128;
        f32x16 acc[2][2], accS[2][2];
        zero_acc(accS);
        {
            auto al = [&](int r, int k) { return *(const uint4*)(zq + (size_t)r * ZE_LD + k); };
            auto bl = [&](int r, int k) { return *(const uint4*)(zk + (size_t)r * ZE_LD + k); };
            gemm_kloop1(accS, al, bl, 2, lds, tid);
        }
        float l2gp = l2g;
        asm volatile("" : "+v"(l2gp));
        int l31p = l31;
        asm volatile("" : "+v"(l31p));
#pragma unroll
        for (int mi = 0; mi < 2; ++mi) {
            const int i = wm * 64 + mi * 32 + l31p;
#pragma unroll
            for (int nj = 0; nj < 2; ++nj)
#pragma unroll
                for (int q4 = 0; q4 < 4; ++q4) {
                    const int jj = wn * 32 + nj * 64 + 8 * q4 + 4 * half;
                    float pv[4];
#pragma unroll
                    for (int r = 0; r < 4; ++r) {
                        const int dj = i - (jj + r);
                        pv[r] = accS[mi][nj][4 * q4 + r] * __builtin_amdgcn_exp2f(l2gp * (float)(dj < 0 ? -dj : dj));
                    }
                    uint2 o; o.x = pk2(pv[0], pv[1]); o.y = pk2(pv[2], pv[3]);
                    *(uint2*)(lds + (jj >> 6) * STAGE_B + i * LDS_PITCH + (jj & 63) * 2) = o;
                }
        }
        __builtin_amdgcn_sched_barrier(0);
        {
            const int srow = tid >> 3, skc = (tid & 7) * 8;
#pragma unroll
            for (int kt = 0; kt < 2; ++kt) {
                uint4 v[4];
#pragma unroll
                for (int i = 0; i < 4; ++i) v[i] = *(const uint4*)(vt + (size_t)(srow + 32 * i) * SEQL + kt * 64 + skc);
#pragma unroll
                for (int i = 0; i < 4; ++i) *(uint4*)(lds + 2 * STAGE_B + kt * STAGE_B + (srow + 32 * i) * LDS_PITCH + skc * 2) = v[i];
                __builtin_amdgcn_sched_barrier(0);
            }
        }
        __syncthreads();
        zero_acc(acc);
        compute_ktile(acc, lds, lds + 2 * STAGE_B, tid, true);
        compute_ktile(acc, lds + STAGE_B, lds + 3 * STAGE_B, tid, true);
#pragma unroll 1
        for (int dirsel = 0; dirsel < 2; ++dirsel) {
            const bf16_t* stp = dirsel == 0 ? stf : stb;
            auto al = [&](int r, int k) {
                const uint4 v = *(const uint4*)(zq + (size_t)r * ZE_LD + k);
                const float s = __builtin_amdgcn_exp2f(l2g * (dirsel == 0 ? (float)r : (float)(127 - r)));
                return scale8(v, s);
            };
            auto bl = [&](int r, int k) { return *(const uint4*)(stp + r * 128 + k); };
            gemm_kloop1(acc, al, bl, 2, lds, tid);
        }
        float s1[2], s2[2];
#pragma unroll
        for (int mi = 0; mi < 2; ++mi) {
            float a = 0.f, q = 0.f;
#pragma unroll
            for (int nj = 0; nj < 2; ++nj)
#pragma unroll
                for (int e = 0; e < 16; ++e) { const float v = acc[mi][nj][e]; a += v; q += v * v; }
            a += __shfl_xor(a, 32); q += __shfl_xor(q, 32);
            s1[mi] = a; s2[mi] = q;
            if (half == 0) stat[(wm * 64 + mi * 32 + l31) * 2 + wn] = make_float2(a, q);
        }
        __syncthreads();
#pragma unroll
        for (int mi = 0; mi < 2; ++mi) {
            const int i = wm * 64 + mi * 32 + l31;
            const float2 o = stat[i * 2 + (wn ^ 1)];
            const float mean = (s1[mi] + o.x) * (1.f / 128.f);
            const float var = (s2[mi] + o.y) * (1.f / 128.f) - mean * mean;
            const float rstd = rsqrtf(fmaxf(var, 0.f) + EPSF);
            bf16_t* zr = Z + (m0 + i) * ZE_LD;
            float gg[2][4][4];
#pragma unroll
            for (int nj = 0; nj < 2; ++nj)
#pragma unroll
                for (int q4 = 0; q4 < 4; ++q4) {
                    const int e = wn * 32 + nj * 64 + 8 * q4 + 4 * half;
                    ld4(zr + 1024 + h * 128 + e, gg[nj][q4][0], gg[nj][q4][1], gg[nj][q4][2], gg[nj][q4][3]);
                }
#pragma unroll
            for (int nj = 0; nj < 2; ++nj)
#pragma unroll
                for (int q4 = 0; q4 < 4; ++q4) {
                    const int e = wn * 32 + nj * 64 + 8 * q4 + 4 * half;
                    st4(zr + h * 128 + e,
                        (acc[mi][nj][4 * q4] - mean) * rstd * siluf_(gg[nj][q4][0]), (acc[mi][nj][4 * q4 + 1] - mean) * rstd * siluf_(gg[nj][q4][1]),
                        (acc[mi][nj][4 * q4 + 2] - mean) * rstd * siluf_(gg[nj][q4][2]), (acc[mi][nj][4 * q4 + 3] - mean) * rstd * siluf_(gg[nj][q4][3]));
                }
        }
        __syncthreads();
    }
}

__device__ __forceinline__ void phase_na(const Params& p, int j, unsigned char* lds, int hb, int wv) {
    bf16_t* Z = (bf16_t*)(p.ws + OFF_Z);
    const bf16_t* VT = (const bf16_t*)(p.ws + OFF_Z + ZO_VT);
    float* btab = (float*)(lds + 4 * STAGE_B);
    const int tid = tidx();
    const int lane = tid & 63, a = tid >> 6;
    const int l15 = lane & 15, g = lane >> 4;
    const int kw = (a == 0) ? 0 : (a == 1) ? 8 : (a == 2) ? 24 : 32;
    const int cq = a * 16 + l15;
    int cs = cq - 8; cs = cs < 0 ? 0 : (cs > 48 ? 48 : cs);
    const int srow = tid >> 3, sc8 = (tid & 7) * 8;
    const unsigned koff = (unsigned)(srow * ZO_LD + sc8), voff = (unsigned)(srow * SEQL + sc8);
    const bool xmap = (gridDim.x == 256);
    const int RPB = xmap ? 2 : 16;
    for (int it = 0;; ++it) {
        if (xmap && it >= 24) break;
        int bh, r0;
        if (xmap) { bh = it * 8 + (blockIdx.x & 7); r0 = ((blockIdx.x >> 3) * 2 + hb) * RPB; }
        else { const int c = it * VG + VB; if (c >= 192 * 8) break; bh = c >> 3; r0 = (c & 7) * 16; }
        const int b = bh >> 4, h = bh & 15;
        __syncthreads();
        for (int i = tid; i < 15 * 32; i += 256) {
            const int rr = i >> 5, cc = i & 31;
            btab[i] = cc < 31 ? p.rel_bias[(((size_t)j * 16 + h) * 15 + rr) * 31 + cc] : 0.f;
        }
        const bf16_t* vtb = VT + ((size_t)(b * 16 + h) * 64) * SEQL;
#pragma unroll 1
        for (int r = r0; r < r0 + RPB; ++r) {
            int rs = r - 4; rs = rs < 0 ? 0 : (rs > 120 ? 120 : rs);
            const size_t tokq = (size_t)b * SEQL + r * 64 + cq;
            bf16_t* zq = Z + tokq * ZO_LD + h * 64;
            u32x4 st[16];
            {
                const bf16_t* kbase = Z + ((size_t)b * SEQL + rs * 64) * ZO_LD + 1024 + h * 64;
#pragma unroll
                for (int i = 0; i < 16; ++i) st[i] = *(const u32x4*)(kbase + (size_t)(32 * i) * ZO_LD + koff);
            }
            const bf16x8 q0 = *(const bf16x8*)(zq + g * 8);
            const bf16x8 q1 = *(const bf16x8*)(zq + 32 + g * 8);
            __syncthreads();
#pragma unroll
            for (int i = 0; i < 16; ++i) *(u32x4*)(lds + (srow + 32 * i) * LDS_PITCH + sc8 * 2) = st[i];
            __syncthreads();
            f32x4 S[8][2];
#pragma unroll
            for (int kr = 0; kr < 8; ++kr) {
                const float* rbr = btab + (rs + kr - r + 7) * 32;
#pragma unroll
                for (int kb = 0; kb < 2; ++kb) {
                    const unsigned char* kp = lds + (kr * 64 + kw + kb * 16 + l15) * LDS_PITCH + g * 16;
                    const bf16x8 k0 = *(const bf16x8*)kp;
                    const bf16x8 k1 = *(const bf16x8*)(kp + 64);
                    f32x4 s = {0.f, 0.f, 0.f, 0.f};
                    s = __builtin_amdgcn_mfma_f32_16x16x32_bf16(k0, q0, s, 0, 0, 0);
                    s = __builtin_amdgcn_mfma_f32_16x16x32_bf16(k1, q1, s, 0, 0, 0);
#pragma unroll
                    for (int e = 0; e < 4; ++e) {
                        const int kc = kw + kb * 16 + 4 * g + e;
                        int dc = kc - cq + 15; dc = dc < 0 ? 0 : (dc > 30 ? 30 : dc);
                        const bool valid = (kc >= cs) && (kc < cs + 16);
                        s[e] = valid ? s[e] + rbr[dc] : -1e30f;
                    }
                    S[kr][kb] = s;
                }
            }
            u32x4 sv[16];
            const bf16_t* vbase = vtb + rs * 64;
#pragma unroll
            for (int i = 0; i < 8; ++i) {
                sv[i] = *(const u32x4*)(vbase + (size_t)(32 * (i & 1)) * SEQL + (i >> 1) * 64 + voff);
            }
            float mx = -1e30f;
#pragma unroll
            for (int kr = 0; kr < 8; ++kr)
#pragma unroll
                for (int kb = 0; kb < 2; ++kb)
#pragma unroll
                    for (int e = 0; e < 4; ++e) mx = fmaxf(mx, S[kr][kb][e]);
            mx = fmaxf(mx, __shfl_xor(mx, 16));
            mx = fmaxf(mx, __shfl_xor(mx, 32));
            float sum = 0.f;
            u32x4 P[8];
#pragma unroll
            for (int kr = 0; kr < 8; ++kr) {
                float ev[8];
#pragma unroll
                for (int kb = 0; kb < 2; ++kb)
#pragma unroll
                    for (int e = 0; e < 4; ++e) { ev[kb * 4 + e] = __expf(S[kr][kb][e] - mx); sum += ev[kb * 4 + e]; }
                P[kr].x = pk2(ev[0], ev[1]); P[kr].y = pk2(ev[2], ev[3]); P[kr].z = pk2(ev[4], ev[5]); P[kr].w = pk2(ev[6], ev[7]);
            }
#pragma unroll
            for (int i = 8; i < 16; ++i) {
                sv[i] = *(const u32x4*)(vbase + (size_t)(32 * (i & 1)) * SEQL + (i >> 1) * 64 + voff);
            }
            sum += __shfl_xor(sum, 16);
            sum += __shfl_xor(sum, 32);
            const float rinv = 1.f / sum;
            __syncthreads();
#pragma unroll
            for (int i = 0; i < 16; ++i) *(u32x4*)(lds + (srow + 32 * i) * LDS_PITCH + sc8 * 2) = sv[i];
            __syncthreads();
            f32x4 O[4];
#pragma unroll
            for (int blk = 0; blk < 4; ++blk) O[blk] = (f32x4){0.f, 0.f, 0.f, 0.f};
#pragma unroll
            for (int kr = 0; kr < 8; ++kr) {
                const bf16x8 pf = (bf16x8)P[kr];
#pragma unroll
                for (int blk = 0; blk < 4; ++blk) {
                    const unsigned char* vp = lds + (kr * 64 + blk * 16 + l15) * LDS_PITCH + (kw + 4 * g) * 2;
                    const uint2 lo = *(const uint2*)vp;
                    const uint2 hi = *(const uint2*)(vp + 32);
                    u32x4 vu; vu.x = lo.x; vu.y = lo.y; vu.z = hi.x; vu.w = hi.y;
                    O[blk] = __builtin_amdgcn_mfma_f32_16x16x32_bf16((bf16x8)vu, pf, O[blk], 0, 0, 0);
                }
            }
            const bf16_t* zg = Z + tokq * ZO_LD + 2048 + h * 64;
            float go[4][4];
#pragma unroll
            for (int blk = 0; blk < 4; ++blk) ld4(zg + blk * 16 + 4 * g, go[blk][0], go[blk][1], go[blk][2], go[blk][3]);
#pragma unroll
            for (int blk = 0; blk < 4; ++blk) {
                const int dh = blk * 16 + 4 * g;
                st4(zq + dh, O[blk][0] * rinv * siluf_(go[blk][0]), O[blk][1] * rinv * siluf_(go[blk][1]), O[blk][2] * rinv * siluf_(go[blk][2]), O[blk][3] * rinv * siluf_(go[blk][3]));
            }
        }
    }
}

constexpr int N_PHASES = 32;
__device__ __forceinline__ void run_phase(const Params& p, int ph, unsigned char* lds, unsigned char* lds0, int hb, int wv) {
    if (ph >= 100) return;
    if (ph == 0) { phase_prologue(p, lds, hb, wv); return; }
    if (ph == 31) { phase_norm(p, 4, hb, wv); return; }
    int q = ph - 1;
    const int pair = q / 15; q %= 15;
    if (q < 11) {
        const int L = pair * 2, j = pair;
        switch (q) {
            case 0: phase_norm(p, L, hb, wv); break;
            case 1: phase_inproj_even(p, j, lds0, hb, wv); break;
            case 2: phase_s5consts(p, j, lds, hb, wv); break;
            case 3: phase_s5A(p, lds0, hb, wv); break;
            case 4: phase_s5scan(p, j, hb, wv); break;
            case 5: phase_s5main(p, j, lds0, hb, wv); break;
            case 6: phase_glu(p, j, lds0, hb, wv); break;
            case 7: phase_ret1(p, lds, hb, wv); break;
            case 8: phase_ret2(p, hb, wv); break;
            case 9: phase_ret3(p, lds, hb, wv); break;
            default: phase_outproj(p, L, lds0, hb, wv); break;
        }
    } else {
        const int L = pair * 2 + 1, j = pair;
        switch (q - 11) {
            case 0: phase_norm(p, L, hb, wv); break;
            case 1: phase_inproj_odd(p, j, lds0, hb, wv); break;
            case 2: phase_na(p, j, lds, hb, wv); break;
            default: phase_outproj(p, L, lds0, hb, wv); break;
        }
    }
}

#ifndef PROBE_PH
#define PROBE_PH 0
#define PROBE_N 0
#endif
__device__ __forceinline__ void grid_barrier(unsigned* ctr, unsigned target, int wv) {
    asm volatile("s_waitcnt vmcnt(0)" ::: "memory");
    __syncthreads();
    if (wv == 0 && lane_id() == 0) {
        __builtin_amdgcn_fence(__ATOMIC_RELEASE, "agent");
        asm volatile("s_waitcnt vmcnt(0)" ::: "memory");
        __hip_atomic_fetch_add(ctr, 1u, __ATOMIC_RELAXED, __HIP_MEMORY_SCOPE_AGENT);
        while (__hip_atomic_load(ctr, __ATOMIC_RELAXED, __HIP_MEMORY_SCOPE_AGENT) < target) { }
        __builtin_amdgcn_fence(__ATOMIC_ACQUIRE, "agent");
        asm volatile("s_waitcnt vmcnt(0)" ::: "memory");
    }
    __syncthreads();
}

__global__ void __launch_bounds__(512, 2) fwd_megakernel(Params p_in, int n_extra, int probe_ph) {
    __shared__ __attribute__((aligned(16))) unsigned char lds_all[2 * LDS_TOTAL];
    const Params& p = p_in;
    const int wv = __builtin_amdgcn_readfirstlane((int)(threadIdx.x >> 6));
    const int hb = wv >> 2;
    unsigned char* lds = lds_all + hb * LDS_TOTAL;
    cg::grid_group grid = cg::this_grid();
    unsigned* bar = (unsigned*)(p.ws + OFF_BAR);
    if (blockIdx.x == 0 && threadIdx.x == 0) __hip_atomic_store(bar, 0u, __ATOMIC_RELAXED, __HIP_MEMORY_SCOPE_AGENT);
    const int total = N_PHASES + n_extra;
#pragma unroll 1
    for (int it = 0; it < total; ++it) {
        const int ph = it < N_PHASES ? it : probe_ph + (it - N_PHASES);
        run_phase(p, ph, lds, lds_all, hb, wv);
        if (it + 1 < total) {
            if (it == 0) grid.sync();
            else grid_barrier(bar, (unsigned)it * gridDim.x, wv);
        }
    }
}

extern "C" void kernel_launch(void* const* d_in, const int* in_sizes, int n_in, void* d_out, int out_size, void* d_ws, size_t ws_size,
                              hipStream_t stream) {
    static int grid_blocks = 0;
    if (!grid_blocks) {
        int dev = 0, cus = 0, per_cu = 0;
        hipGetDevice(&dev);
        hipDeviceGetAttribute(&cus, hipDeviceAttributeMultiprocessorCount, dev);
        hipOccupancyMaxActiveBlocksPerMultiprocessor(&per_cu, fwd_megakernel, 512, 0);
        if (per_cu < 1) per_cu = 1;
        if (per_cu > 1) per_cu = 1;
        grid_blocks = cus * per_cu;
    }
    Params p{};
    p.x_prompt = (const float*)d_in[0]; p.x_sample = (const float*)d_in[1]; p.c_prompt = (const float*)d_in[2]; p.c_sample = (const float*)d_in[3];
    p.norm_pre = (const float*)d_in[4]; p.norm_post = (const float*)d_in[5]; p.w_mod = (const float*)d_in[6]; p.b_mod = (const float*)d_in[7];
    p.w_in_ab = (const float*)d_in[8]; p.w_out_ab = (const float*)d_in[9]; p.a_re = (const float*)d_in[10]; p.a_im = (const float*)d_in[11];
    p.log_step = (const float*)d_in[12]; p.b_re = (const float*)d_in[13]; p.b_im = (const float*)d_in[14]; p.c_re = (const float*)d_in[15];
    p.c_im = (const float*)d_in[16]; p.ssm_d = (const float*)d_in[17]; p.w_glu = (const float*)d_in[18]; p.w_in_c = (const float*)d_in[19];
    p.w_out_c = (const float*)d_in[20]; p.rel_bias = (const float*)d_in[21];
    p.out = (float*)d_out; p.ws = (unsigned char*)d_ws;
    int n_extra = PROBE_N, probe_ph = PROBE_PH;
    void* args[] = {&p, &n_extra, &probe_ph};
    hipError_t e = hipLaunchCooperativeKernel((void*)fwd_megakernel, dim3(grid_blocks), dim3(512), args, 0, stream);
    if (e != hipSuccess) fprintf(stderr, "cooperative launch failed: %s (grid %d)\n", hipGetErrorString(e), grid_blocks);
}
```

```cpp
#include <hip/hip_runtime.h>
#include <hip/hip_cooperative_groups.h>
#include <cstdio>
#include <cstdint>
namespace cg = cooperative_groups;

typedef unsigned short bf16_t;
typedef short bf16x8 __attribute__((ext_vector_type(8)));
typedef float f32x4 __attribute__((ext_vector_type(4)));
typedef float f32x16 __attribute__((ext_vector_type(16)));
typedef unsigned u32x4 __attribute__((ext_vector_type(4)));

constexpr int T_TOK = 98304, SEQL = 8192, DM = 1024;
constexpr float EPSF = 1e-6f;

constexpr size_t OFF_Z = 0;
constexpr size_t SZ_Z = 805306368ull;
constexpr size_t OFF_B = OFF_Z + SZ_Z;
constexpr size_t SZ_B = 201326592ull;
constexpr size_t OFF_W = OFF_B + SZ_B;
constexpr size_t W_IN_AB = 0;
constexpr size_t W_OUT_AB = W_IN_AB + 2ull * 3145728;
constexpr size_t W_GLU = W_OUT_AB + 2ull * 1048576;
constexpr size_t W_IN_C = W_GLU + 2ull * 262144;
constexpr size_t W_OUT_C = W_IN_C + 2ull * 4194304;
constexpr size_t W_TOTAL = W_OUT_C + 2ull * 1048576;
constexpr size_t OFF_MOD = OFF_W + W_TOTAL * 2;
constexpr size_t OFF_COS = OFF_MOD + 4ull * 12 * 3072 * 4;
constexpr size_t OFF_SIN = OFF_COS + 8192ull * 64 * 4;
constexpr size_t WS_END = OFF_SIN + 8192ull * 64 * 4;
constexpr size_t OFF_BAR = WS_END;
constexpr int ZE_LD = 2048;
constexpr size_t ZE_US = (size_t)T_TOK * ZE_LD * 2;
constexpr size_t ZE_VT = ZE_US + 100663296ull;
constexpr size_t ZE_KT = ZE_VT + 100663296ull;
constexpr size_t ZE_E = ZE_KT + 100663296ull;
constexpr size_t ZE_CARRY = ZE_E + 50331648ull;
constexpr int ZO_LD = 3072;
constexpr size_t ZO_VT = (size_t)T_TOK * ZO_LD * 2;
constexpr size_t B_YG = 0;
constexpr size_t B_KMAT = 100663296ull;
constexpr size_t B_EMAT = B_KMAT + 83886080ull;

struct Params {
    const float *x_prompt, *x_sample, *c_prompt, *c_sample, *norm_pre, *norm_post, *w_mod, *b_mod;
    const float *w_in_ab, *w_out_ab, *a_re, *a_im, *log_step, *b_re, *b_im, *c_re, *c_im, *ssm_d, *w_glu;
    const float *w_in_c, *w_out_c, *rel_bias;
    float* out;
    unsigned char* ws;
    int hb;
    int pad_;
};

__device__ __forceinline__ float bf2f(unsigned short u) { return __uint_as_float(((unsigned)u) << 16); }
__device__ __forceinline__ unsigned pk2(float lo, float hi) {
    unsigned r;
    asm("v_cvt_pk_bf16_f32 %0, %1, %2" : "=v"(r) : "v"(lo), "v"(hi));
    return r;
}
__device__ __forceinline__ bf16_t f2bf(float v) { return (bf16_t)(pk2(v, 0.f) & 0xffffu); }
__device__ __forceinline__ float sigmoidf_(float x) { return 1.f / (1.f + __expf(-x)); }
__device__ __forceinline__ float siluf_(float x) { return x / (1.f + __expf(-x)); }
__device__ __forceinline__ float gelu_tanh(float y) {
    const float u = 0.7978845608028654f * (y + 0.044715f * y * y * y);
    const float e = __expf(2.f * u);
    const float th = 1.f - 2.f / (e + 1.f);
    return 0.5f * y * (1.f + th);
}
__device__ __forceinline__ void st4(bf16_t* dst, float a, float b, float c, float d) {
    uint2 v; v.x = pk2(a, b); v.y = pk2(c, d);
    *(uint2*)dst = v;
}
__device__ __forceinline__ void ld4(const bf16_t* src, float& a, float& b, float& c, float& d) {
    const uint2 v = *(const uint2*)src;
    a = __uint_as_float(v.x << 16); b = __uint_as_float(v.x & 0xffff0000u);
    c = __uint_as_float(v.y << 16); d = __uint_as_float(v.y & 0xffff0000u);
}
__device__ __forceinline__ uint4 scale8(uint4 v, float s) {
    uint4 o;
    o.x = pk2(__uint_as_float(v.x << 16) * s, __uint_as_float(v.x & 0xffff0000u) * s);
    o.y = pk2(__uint_as_float(v.y << 16) * s, __uint_as_float(v.y & 0xffff0000u) * s);
    o.z = pk2(__uint_as_float(v.z << 16) * s, __uint_as_float(v.z & 0xffff0000u) * s);
    o.w = pk2(__uint_as_float(v.w << 16) * s, __uint_as_float(v.w & 0xffff0000u) * s);
    return o;
}
__device__ __forceinline__ const float* x_row(const Params& p, int row) {
    return row < 4 * SEQL ? p.x_prompt + (size_t)row * DM : p.x_sample + (size_t)(row - 4 * SEQL) * DM;
}
__device__ __forceinline__ const float* c_row(const Params& p, int b) {
    return b < 4 ? p.c_prompt + (size_t)b * DM : p.c_sample + (size_t)(b - 4) * DM;
}
__device__ __forceinline__ float log2_gamma(int h) { return log2f(1.f - exp2f(-5.f - (float)h)); }

__device__ __forceinline__ int lane_id() { int l; asm volatile("v_mbcnt_lo_u32_b32 %0, -1, 0\n\tv_mbcnt_hi_u32_b32 %0, -1, %0" : "=v"(l)); return l; }
#define tidx() tid_of(wv & 3)
#define t512x() tid_of(wv)
__device__ __forceinline__ int tid_of(int w) { int t = w * 64 + lane_id(); asm volatile("" : "+v"(t)); return t; }
#define VB ((int)blockIdx.x * 2 + hb)
#define VG ((int)gridDim.x * 2)
constexpr int LDS_PITCH = 144;
constexpr int STAGE_B = 128 * LDS_PITCH;
constexpr int LDS_TOTAL = 4 * STAGE_B + 2048;

__device__ __forceinline__ void compute_ktile(f32x16 (&acc)[2][2], const unsigned char* Ab, const unsigned char* Bb, int tid, bool swap) {
    const int lane = tid & 63, wave = tid >> 6, wm = wave >> 1, wn = wave & 1;
    const int l31 = lane & 31, half = lane >> 5;
    const unsigned char* ap = Ab + (wm * 64 + l31) * LDS_PITCH + half * 16;
    const unsigned char* bp = Bb + (wn * 32 + l31) * LDS_PITCH + half * 16;
    if (swap) {
#pragma unroll
        for (int ks = 0; ks < 4; ++ks) {
            bf16x8 a[2], b[2];
            a[0] = *(const bf16x8*)(ap + ks * 32);
            a[1] = *(const bf16x8*)(ap + 32 * LDS_PITCH + ks * 32);
            b[0] = *(const bf16x8*)(bp + ks * 32);
            b[1] = *(const bf16x8*)(bp + 64 * LDS_PITCH + ks * 32);
#pragma unroll
            for (int mi = 0; mi < 2; ++mi)
#pragma unroll
                for (int nj = 0; nj < 2; ++nj) acc[mi][nj] = __builtin_amdgcn_mfma_f32_32x32x16_bf16(b[nj], a[mi], acc[mi][nj], 0, 0, 0);
        }
    } else {
#pragma unroll
        for (int ks = 0; ks < 4; ++ks) {
            bf16x8 a[2], b[2];
            a[0] = *(const bf16x8*)(ap + ks * 32);
            a[1] = *(const bf16x8*)(ap + 32 * LDS_PITCH + ks * 32);
            b[0] = *(const bf16x8*)(bp + ks * 32);
            b[1] = *(const bf16x8*)(bp + 64 * LDS_PITCH + ks * 32);
#pragma unroll
            for (int mi = 0; mi < 2; ++mi)
#pragma unroll
                for (int nj = 0; nj < 2; ++nj) acc[mi][nj] = __builtin_amdgcn_mfma_f32_32x32x16_bf16(a[mi], b[nj], acc[mi][nj], 0, 0, 0);
        }
    }
}

template <class AL, class BL>
__device__ __forceinline__ void gemm_kloop1(f32x16 (&acc)[2][2], const AL& al, const BL& bl, int nk, unsigned char* lds, int tid, bool swap = true) {
    const int srow = tid >> 3, skc = (tid & 7) * 8;
    uint4 ra[4], rb[4];
#pragma unroll
    for (int i = 0; i < 4; ++i) { ra[i] = al(srow + 32 * i, skc); rb[i] = bl(srow + 32 * i, skc); }
    __syncthreads();
#pragma unroll
    for (int i = 0; i < 4; ++i) {
        *(uint4*)(lds + (srow + 32 * i) * LDS_PITCH + skc * 2) = ra[i];
        *(uint4*)(lds + 2 * STAGE_B + (srow + 32 * i) * LDS_PITCH + skc * 2) = rb[i];
    }
    __syncthreads();
#pragma unroll 1
    for (int kt = 0; kt < nk; ++kt) {
        const int cur = kt & 1;
        const bool more = (kt + 1 < nk);
        if (more) {
            const int k = (kt + 1) * 64 + skc;
#pragma unroll
            for (int i = 0; i < 4; ++i) { ra[i] = al(srow + 32 * i, k); rb[i] = bl(srow + 32 * i, k); }
        }
        compute_ktile(acc, lds + cur * STAGE_B, lds + 2 * STAGE_B + cur * STAGE_B, tid, swap);
        if (more) {
            const int nxt = cur ^ 1;
#pragma unroll
            for (int i = 0; i < 4; ++i) {
                *(uint4*)(lds + nxt * STAGE_B + (srow + 32 * i) * LDS_PITCH + skc * 2) = ra[i];
                *(uint4*)(lds + 2 * STAGE_B + nxt * STAGE_B + (srow + 32 * i) * LDS_PITCH + skc * 2) = rb[i];
            }
        }
        __syncthreads();
    }
}

template <class AL, class BL>
__device__ __forceinline__ void gemm_kloop(f32x16 (&acc)[2][2], const AL& al, const BL& bl, int nk, unsigned char* lds, int tid, bool swap = true) {
    const int srow = tid >> 3, skc = (tid & 7) * 8;
    uint4 ra0[4], rb0[4], ra1[4], rb1[4];
#define GK_LOAD(RA, RB, KT) { const int k_ = (KT) * 64 + skc; _Pragma("unroll") for (int i = 0; i < 4; ++i) { RA[i] = al(srow + 32 * i, k_); RB[i] = bl(srow + 32 * i, k_); } }
#define GK_STORE(RA, RB, BUF) { _Pragma("unroll") for (int i = 0; i < 4; ++i) { \
        *(uint4*)(lds + (BUF) * STAGE_B + (srow + 32 * i) * LDS_PITCH + skc * 2) = RA[i]; \
        *(uint4*)(lds + 2 * STAGE_B + (BUF) * STAGE_B + (srow + 32 * i) * LDS_PITCH + skc * 2) = RB[i]; } }
    const int last = nk - 1;
    GK_LOAD(ra0, rb0, 0);
    GK_LOAD(ra1, rb1, 1);
    __syncthreads();
    GK_STORE(ra0, rb0, 0);
    GK_LOAD(ra0, rb0, (2 < last ? 2 : last));
    __syncthreads();
#pragma unroll 1
    for (int kt = 0; kt < nk; kt += 2) {
        compute_ktile(acc, lds, lds + 2 * STAGE_B, tid, swap);
        GK_STORE(ra1, rb1, 1);
        __builtin_amdgcn_sched_barrier(0);
        GK_LOAD(ra1, rb1, (kt + 3 < last ? kt + 3 : last));
        __syncthreads();
        compute_ktile(acc, lds + STAGE_B, lds + 3 * STAGE_B, tid, swap);
        GK_STORE(ra0, rb0, 0);
        __builtin_amdgcn_sched_barrier(0);
        GK_LOAD(ra0, rb0, (kt + 4 < last ? kt + 4 : last));
        __syncthreads();
    }
#undef GK_LOAD
#undef GK_STORE
}

constexpr int ST2_B = 65536;
__device__ __forceinline__ void compute_ktile256(f32x16 (&acc)[2][4], const unsigned char* Ab, const unsigned char* Bb, int t512) {
    const int lane = t512 & 63, wave = t512 >> 6, wm = wave >> 1, wn = wave & 1;
    const int l31 = lane & 31, half = lane >> 5;
    const int swz = (l31 >> 1) & 7;
    const unsigned char* ap = Ab + (wm * 64 + l31) * 128;
    const unsigned char* bp = Bb + (wn * 128 + l31) * 128;
#pragma unroll
    for (int ks = 0; ks < 4; ++ks) {
        const int off = ((ks * 2 + half) ^ swz) * 16;
        bf16x8 a[2], b[4];
        a[0] = *(const bf16x8*)(ap + off);
        a[1] = *(const bf16x8*)(ap + 32 * 128 + off);
#pragma unroll
        for (int nj = 0; nj < 4; ++nj) b[nj] = *(const bf16x8*)(bp + nj * 32 * 128 + off);
#pragma unroll
        for (int mi = 0; mi < 2; ++mi)
#pragma unroll
            for (int nj = 0; nj < 4; ++nj) acc[mi][nj] = __builtin_amdgcn_mfma_f32_32x32x16_bf16(a[mi], b[nj], acc[mi][nj], 0, 0, 0);
    }
}

template <class AL, class BL>
__device__ __forceinline__ void gemm256_kloop(f32x16 (&acc)[2][4], const AL& al, const BL& bl, int nk, unsigned char* lds0, int t512) {
    const int srow = t512 >> 3;
    const int csrc = ((t512 & 7) ^ ((srow >> 1) & 7)) * 8;
#define G2_ISSUE(BUF, KT) { const int k_ = (KT) * 64 + csrc; _Pragma("unroll") for (int i = 0; i < 4; ++i) { \
        __builtin_amdgcn_global_load_lds((const unsigned*)al(srow + 64 * i, k_), (unsigned*)(lds0 + (BUF) * ST2_B + i * 8192 + t512 * 16), 16, 0, 0); \
        __builtin_amdgcn_global_load_lds((const unsigned*)bl(srow + 64 * i, k_), (unsigned*)(lds0 + (BUF) * ST2_B + 32768 + i * 8192 + t512 * 16), 16, 0, 0); } }
    const int last = nk - 1;
    __syncthreads();
    G2_ISSUE(0, 0);
    __syncthreads();
#pragma unroll 1
    for (int kt = 0; kt < nk; kt += 2) {
        G2_ISSUE(1, (kt + 1));
        compute_ktile256(acc, lds0, lds0 + 32768, t512);
        __syncthreads();
        G2_ISSUE(0, (kt + 2 < last ? kt + 2 : last));
        compute_ktile256(acc, lds0 + ST2_B, lds0 + ST2_B + 32768, t512);
        __syncthreads();
    }
#undef G2_ISSUE
}

#define ROWU(mi, reg) (wm * 64 + (mi) * 32 + 8 * ((reg) >> 2) + ((reg) & 3))
__device__ __forceinline__ void zero_acc256(f32x16 (&acc)[2][4]) {
#pragma unroll
    for (int i = 0; i < 2; ++i)
#pragma unroll
        for (int j = 0; j < 4; ++j)
#pragma unroll
            for (int e = 0; e < 16; ++e) acc[i][j][e] = 0.f;
}
__device__ __forceinline__ bool tile256(int it, int NT, int ntiles, int& mt, int& nt) {
    const int G = gridDim.x, b = blockIdx.x;
    if ((G & 7) == 0) {
        const int s = it * (G >> 3) + (b >> 3);
        if (s >= (ntiles >> 3)) return false;
        mt = (s / NT) * 8 + (b & 7); nt = s % NT;
    } else {
        const int t = it * G + b;
        if (t >= ntiles) return false;
        mt = t / NT; nt = t % NT;
    }
    return true;
}
__device__ __forceinline__ bool tile256_in(int it, int NT, int& mt, int& nt) {
    const int G = gridDim.x, b = blockIdx.x;
    if ((G & 7) == 0) {
        const int NG = NT >> 2;
        const int s = it * (G >> 3) + (b >> 3);
        const int ml = s / NG;
        if (ml >= 192) return false;
        const int x = b & 7;
        mt = (x >> 2) * 192 + ml; nt = (x & 3) * NG + (s - ml * NG);
    } else {
        const int t = it * G + b;
        if (t >= 384 * NT) return false;
        mt = t / NT; nt = t % NT;
    }
    return true;
}

__device__ __forceinline__ void zero_acc(f32x16 (&acc)[2][2]) {
#pragma unroll
    for (int i = 0; i < 2; ++i)
#pragma unroll
        for (int j = 0; j < 2; ++j)
#pragma unroll
            for (int e = 0; e < 16; ++e) acc[i][j][e] = 0.f;
}

__device__ __forceinline__ void transpose_tile(const float* src, int K, int N, bf16_t* dst, int tile, unsigned char* lds, int wv) {
    float* tl = (float*)lds;
    const int ntn = N / 64;
    const int k0 = (tile / ntn) * 64, n0 = (tile % ntn) * 64;
    const int tid = tidx();
    __syncthreads();
#pragma unroll
    for (int i = 0; i < 4; ++i) {
        const int r = (tid >> 4) + 16 * i, c4 = (tid & 15) * 4;
        const float4 v = *(const float4*)(src + (size_t)(k0 + r) * N + n0 + c4);
        tl[r * 65 + c4 + 0] = v.x; tl[r * 65 + c4 + 1] = v.y; tl[r * 65 + c4 + 2] = v.z; tl[r * 65 + c4 + 3] = v.w;
    }
    __syncthreads();
#pragma unroll
    for (int i = 0; i < 2; ++i) {
        const int n = (tid >> 3) + 32 * i, k8 = (tid & 7) * 8;
        uint4 o;
        o.x = pk2(tl[(k8 + 0) * 65 + n], tl[(k8 + 1) * 65 + n]);
        o.y = pk2(tl[(k8 + 2) * 65 + n], tl[(k8 + 3) * 65 + n]);
        o.z = pk2(tl[(k8 + 4) * 65 + n], tl[(k8 + 5) * 65 + n]);
        o.w = pk2(tl[(k8 + 6) * 65 + n], tl[(k8 + 7) * 65 + n]);
        *(uint4*)(dst + (size_t)(n0 + n) * K + k0 + k8) = o;
    }
}

__device__ __forceinline__ void mod_tile(const Params& p, int tile, unsigned char* lds, int wv) {
    float* sc = (float*)lds;
    float* red = (float*)(lds + 49152);
    const int L = tile / 96, n0 = (tile % 96) * 32;
    const int tid = tidx();
    __syncthreads();
    for (int i = tid; i < 12 * 1024; i += 256) {
        const int b = i >> 10, k = i & 1023;
        sc[i] = siluf_(c_row(p, b)[k]);
    }
    __syncthreads();
    const int kg = tid >> 5, col = tid & 31;
    float a[12];
#pragma unroll
    for (int b = 0; b < 12; ++b) a[b] = 0.f;
    const float* w = p.w_mod + (size_t)L * 1024 * 3072 + n0 + col;
#pragma unroll 1
    for (int k0 = kg * 128; k0 < kg * 128 + 128; k0 += 8) {
        float wq[8];
#pragma unroll
        for (int u = 0; u < 8; ++u) wq[u] = w[(size_t)(k0 + u) * 3072];
#pragma unroll
        for (int u = 0; u < 8; ++u)
#pragma unroll
            for (int b = 0; b < 12; ++b) a[b] += sc[b * 1024 + k0 + u] * wq[u];
    }
#pragma unroll
    for (int b = 0; b < 12; ++b) red[(kg * 12 + b) * 32 + col] = a[b];
    __syncthreads();
    for (int i = tid; i < 12 * 32; i += 256) {
        const int b = i >> 5, c = i & 31;
        float s = 0.f;
#pragma unroll
        for (int g = 0; g < 8; ++g) s += red[(g * 12 + b) * 32 + c];
        float* mod = (float*)(p.ws + OFF_MOD);
        mod[((size_t)L * 12 + b) * 3072 + n0 + c] = s + p.b_mod[(size_t)L * 3072 + n0 + c];
    }
}

__device__ __forceinline__ void phase_prologue(const Params& p, unsigned char* lds, int hb, int wv) {
    bf16_t* W = (bf16_t*)(p.ws + OFF_W);
    const int NTR = 4736, NMOD = 384, NROT = 2048;
    for (int t = VB; t < NTR + NMOD + NROT; t += VG) {
        if (t < NTR) {
            const float* src; int K, N; bf16_t* dst; int tile;
            if (t < 1536)      { const int j = t / 768;          tile = t % 768;          src = p.w_in_ab + (size_t)j * 3145728; K = 1024; N = 3072; dst = W + W_IN_AB + (size_t)j * 3145728; }
            else if (t < 2048) { const int j = (t - 1536) / 256; tile = (t - 1536) % 256; src = p.w_out_ab + (size_t)j * 1048576; K = 1024; N = 1024; dst = W + W_OUT_AB + (size_t)j * 1048576; }
            else if (t < 2176) { const int j = (t - 2048) / 64;  tile = (t - 2048) % 64;  src = p.w_glu + (size_t)j * 262144; K = 512; N = 512; dst = W + W_GLU + (size_t)j * 262144; }
            else if (t < 4224) { const int j = (t - 2176) / 1024; tile = (t - 2176) % 1024; src = p.w_in_c + (size_t)j * 4194304; K = 1024; N = 4096; dst = W + W_IN_C + (size_t)j * 4194304; }
            else               { const int j = (t - 4224) / 256; tile = (t - 4224) % 256; src = p.w_out_c + (size_t)j * 1048576; K = 1024; N = 1024; dst = W + W_OUT_C + (size_t)j * 1048576; }
            transpose_tile(src, K, N, dst, tile, lds, wv);
        } else if (t < NTR + NMOD) {
            mod_tile(p, t - NTR, lds, wv);
        } else {
            const int idx = (t - NTR - NMOD) * 256 + tidx();
            const int pos = idx >> 6, i = idx & 63;
            const float inv = powf(10000.f, -(float)(2 * i) / 128.f);
            const float ang = (float)pos * inv;
            float s, c;
            sincosf(ang, &s, &c);
            ((float*)(p.ws + OFF_COS))[idx] = c;
            ((float*)(p.ws + OFF_SIN))[idx] = s;
        }
    }
}

__device__ __forceinline__ void phase_norm(const Params& p, int L, int hb, int wv) {
    const int tid = tidx();
    const int lane = tid & 63, wave = tid >> 6;
    bf16_t* B = (bf16_t*)(p.ws + OFF_B);
    const float* mod = (const float*)(p.ws + OFF_MOD);
#define XBF(r) ((bf16_t*)((unsigned char*)p.out + (size_t)(r) * 4096 + 2048))
    float4 xn[4];
    uint2 xbn[4] = {make_uint2(0u, 0u), make_uint2(0u, 0u), make_uint2(0u, 0u), make_uint2(0u, 0u)};
    uint2 yn[4];
    {
        const int row = VB * 4 + wave;
#pragma unroll
        for (int i = 0; i < 4; ++i) {
            if (L <= 1) { const f32x4 t_ = __builtin_nontemporal_load((const f32x4*)(x_row(p, row) + i * 256 + lane * 4)); xn[i] = make_float4(t_[0], t_[1], t_[2], t_[3]); }
            else { xbn[i] = *(const uint2*)(XBF(row) + i * 256 + lane * 4); xn[i] = make_float4(0.f, 0.f, 0.f, 0.f); }
            yn[i] = (L >= 1) ? *(const uint2*)(B + (size_t)row * DM + i * 256 + lane * 4) : make_uint2(0u, 0u);
        }
    }
    float4 g4a[4], n4a[4], sha[4], scla[4], npa[4];
#pragma unroll
    for (int i = 0; i < 4; ++i) {
        g4a[i] = n4a[i] = sha[i] = scla[i] = npa[i] = make_float4(0.f, 0.f, 0.f, 0.f);
        if (L >= 1) n4a[i] = *(const float4*)(p.norm_post + (size_t)(L - 1) * DM + i * 256 + lane * 4);
        if (L <= 3) npa[i] = *(const float4*)(p.norm_pre + (size_t)L * DM + i * 256 + lane * 4);
    }
    int bprev = -1;
    for (int t = VB; t < T_TOK / 4; t += VG) {
        const int row = t * 4 + wave;
        const int b = row / SEQL;
        if (b != bprev) {
            bprev = b;
#pragma unroll
            for (int i = 0; i < 4; ++i) {
                if (L >= 1) g4a[i] = *(const float4*)(mod + ((size_t)(L - 1) * 12 + b) * 3072 + 2048 + i * 256 + lane * 4);
                if (L <= 3) {
                    sha[i] = *(const float4*)(mod + ((size_t)L * 12 + b) * 3072 + i * 256 + lane * 4);
                    scla[i] = *(const float4*)(mod + ((size_t)L * 12 + b) * 3072 + 1024 + i * 256 + lane * 4);
                }
            }
        }
        float x[16], y[16];
#pragma unroll
        for (int i = 0; i < 4; ++i) {
            if (L <= 1) { x[4 * i] = xn[i].x; x[4 * i + 1] = xn[i].y; x[4 * i + 2] = xn[i].z; x[4 * i + 3] = xn[i].w; }
            else {
                x[4 * i] = __uint_as_float(xbn[i].x << 16); x[4 * i + 1] = __uint_as_float(xbn[i].x & 0xffff0000u);
                x[4 * i + 2] = __uint_as_float(xbn[i].y << 16); x[4 * i + 3] = __uint_as_float(xbn[i].y & 0xffff0000u);
            }
            y[4 * i] = __uint_as_float(yn[i].x << 16); y[4 * i + 1] = __uint_as_float(yn[i].x & 0xffff0000u);
            y[4 * i + 2] = __uint_as_float(yn[i].y << 16); y[4 * i + 3] = __uint_as_float(yn[i].y & 0xffff0000u);
        }
        {
            const int tn = (t + VG < T_TOK / 4) ? t + VG : t;
            const int rown = tn * 4 + wave;
#pragma unroll
            for (int i = 0; i < 4; ++i) {
                if (L <= 1) { const f32x4 t_ = __builtin_nontemporal_load((const f32x4*)(x_row(p, rown) + i * 256 + lane * 4)); xn[i] = make_float4(t_[0], t_[1], t_[2], t_[3]); }
                else xbn[i] = *(const uint2*)(XBF(rown) + i * 256 + lane * 4);
                if (L >= 1) yn[i] = *(const uint2*)(B + (size_t)rown * DM + i * 256 + lane * 4);
            }
        }
        if (L >= 1) {
            float ss = 0.f;
#pragma unroll
            for (int e = 0; e < 16; ++e) ss += y[e] * y[e];
#pragma unroll
            for (int o = 32; o >= 1; o >>= 1) ss += __shfl_xor(ss, o);
            const float ry = rsqrtf(ss * (1.f / 1024.f) + EPSF);
#pragma unroll
            for (int i = 0; i < 4; ++i) {
                const int c = i * 256 + lane * 4;
                const float4 g4 = g4a[i];
                const float4 n4 = n4a[i];
                x[4 * i + 0] += g4.x * (y[4 * i + 0] * ry * n4.x);
                x[4 * i + 1] += g4.y * (y[4 * i + 1] * ry * n4.y);
                x[4 * i + 2] += g4.z * (y[4 * i + 2] * ry * n4.z);
                x[4 * i + 3] += g4.w * (y[4 * i + 3] * ry * n4.w);
                if (L == 4) {
                    f32x4 o; o[0] = x[4 * i]; o[1] = x[4 * i + 1]; o[2] = x[4 * i + 2]; o[3] = x[4 * i + 3];
                    __builtin_nontemporal_store(o, (f32x4*)(p.out + (size_t)row * DM + c));
                } else {
                    st4(XBF(row) + c, x[4 * i], x[4 * i + 1], x[4 * i + 2], x[4 * i + 3]);
                }
            }
        }
        if (L <= 3) {
            float ss = 0.f;
#pragma unroll
            for (int e = 0; e < 16; ++e) ss += x[e] * x[e];
#pragma unroll
            for (int o = 32; o >= 1; o >>= 1) ss += __shfl_xor(ss, o);
            const float rx = rsqrtf(ss * (1.f / 1024.f) + EPSF);
#pragma unroll
            for (int i = 0; i < 4; ++i) {
                const int c = i * 256 + lane * 4;
                const float4 sh = sha[i];
                const float4 scl = scla[i];
                const float4 n4 = npa[i];
                const float h0 = x[4 * i + 0] * rx * n4.x * (1.f + scl.x) + sh.x;
                const float h1 = x[4 * i + 1] * rx * n4.y * (1.f + scl.y) + sh.y;
                const float h2 = x[4 * i + 2] * rx * n4.z * (1.f + scl.z) + sh.z;
                const float h3 = x[4 * i + 3] * rx * n4.w * (1.f + scl.w) + sh.w;
                st4(B + (size_t)row * DM + c, h0, h1, h2, h3);
            }
        }
    }
}

__device__ __forceinline__ void phase_inproj_even(const Params& p, int j, unsigned char* lds0, int hb, int wv) {
    const bf16_t* H = (const bf16_t*)(p.ws + OFF_B);
    const bf16_t* Wt = (const bf16_t*)(p.ws + OFF_W) + W_IN_AB + (size_t)j * 3145728;
    bf16_t* Z = (bf16_t*)(p.ws + OFF_Z);
    bf16_t* VT = (bf16_t*)(p.ws + OFF_Z + ZE_VT);
    bf16_t* KT = (bf16_t*)(p.ws + OFF_Z + ZE_KT);
    const float* COS = (const float*)(p.ws + OFF_COS);
    const float* SIN = (const float*)(p.ws + OFF_SIN);
    const int t512 = t512x();
    for (int it = 0;; ++it) {
        int mt, nt;
        if (!tile256_in(it, 12, mt, nt)) break;
        const int m0 = mt * 256, n0 = nt * 256;
        const bf16_t* Hm = H + (size_t)m0 * 1024;
        const bf16_t* Wn = Wt + (size_t)n0 * 1024;
        auto al = [&](int r, int k) { return Hm + (unsigned)(r * 1024 + k); };
        auto bl = [&](int r, int k) { return Wn + (unsigned)(r * 1024 + k); };
        f32x16 acc[2][4];
        zero_acc256(acc);
        gemm256_kloop(acc, al, bl, 16, lds0, t512);
        int tq = t512;
        asm volatile("" : "+v"(tq));
        const int lane = tq & 63, wave = tq >> 6, wm = wave >> 1, wn = wave & 1, l31 = lane & 31, half = lane >> 5;
        const int cw = n0 + wn * 128;
        const int seg = cw >> 9;
        const int bb = m0 / SEQL;
        const int rbase = m0 + wm * 64 + 4 * half;
        if (seg == 2) {
#pragma unroll
            for (int mi = 0; mi < 2; ++mi)
#pragma unroll
                for (int nj = 0; nj < 4; ++nj) {
                    const int n = cw - 1024 + nj * 32 + l31;
#pragma unroll
                    for (int q4 = 0; q4 < 4; ++q4) {
                        const int pos = (rbase % SEQL) + mi * 32 + 8 * q4;
                        st4(VT + ((size_t)bb * 512 + n) * SEQL + pos, acc[mi][nj][4 * q4], acc[mi][nj][4 * q4 + 1], acc[mi][nj][4 * q4 + 2], acc[mi][nj][4 * q4 + 3]);
                    }
                }
        } else if (seg <= 1) {
            const float ksc = (seg == 1) ? 0.08838834764831845f : 1.f;
            const int hd = (cw & 511) >> 7;
#pragma unroll
            for (int mi = 0; mi < 2; ++mi)
#pragma unroll
                for (int nj = 0; nj < 2; ++nj) {
                    const int d = nj * 32 + l31;
#pragma unroll
                    for (int hq = 0; hq < 2; ++hq) {
                        float cc8[8], sn8[8];
#pragma unroll
                        for (int r8 = 0; r8 < 8; ++r8) {
                            const int pos = (rbase + mi * 32 + 8 * (hq * 2 + (r8 >> 2)) + (r8 & 3)) % SEQL;
                            cc8[r8] = COS[pos * 64 + d]; sn8[r8] = SIN[pos * 64 + d];
                        }
#pragma unroll
                        for (int qq = 0; qq < 2; ++qq) {
                            const int q4 = hq * 2 + qq;
                            float o1[4], o2[4];
                            const int row0 = rbase + mi * 32 + 8 * q4;
#pragma unroll
                            for (int r = 0; r < 4; ++r) {
                                const int row = row0 + r;
                                const float cc = cc8[qq * 4 + r], sn = sn8[qq * 4 + r];
                                const float x1 = acc[mi][nj][4 * q4 + r], x2 = acc[mi][nj + 2][4 * q4 + r];
                                o1[r] = (x1 * cc - x2 * sn) * ksc;
                                o2[r] = (x1 * sn + x2 * cc) * ksc;
                                Z[(size_t)row * ZE_LD + cw + d] = f2bf(o1[r]);
                                Z[(size_t)row * ZE_LD + cw + 64 + d] = f2bf(o2[r]);
                            }
                            if (seg == 1) {
                                bf16_t* kt = KT + ((size_t)(bb * 4 + hd) * 128) * SEQL + (row0 % SEQL);
                                st4(kt + (size_t)d * SEQL, o1[0], o1[1], o1[2], o1[3]);
                                st4(kt + (size_t)(64 + d) * SEQL, o2[0], o2[1], o2[2], o2[3]);
                            }
                        }
                    }
                }
        } else if (seg == 4) {
            bf16_t* US = (bf16_t*)(p.ws + OFF_Z + ZE_US);
#pragma unroll
            for (int mi = 0; mi < 2; ++mi)
#pragma unroll
                for (int nj = 0; nj < 4; ++nj) {
                    const int n = cw - 2048 + nj * 32 + l31;
                    const int g = n >> 4, i = n & 15;
#pragma unroll
                    for (int reg = 0; reg < 16; ++reg) {
                        const int row = rbase + mi * 32 + 8 * (reg >> 2) + (reg & 3);
                        US[(((size_t)(row >> 6) * 32 + g) * 64 + (row & 63)) * 16 + i] = f2bf(acc[mi][nj][reg]);
                    }
                }
        } else {
            const int cb = (seg == 3) ? cw - 512 : cw - 1024;
#pragma unroll
            for (int mi = 0; mi < 2; ++mi)
#pragma unroll
                for (int nj = 0; nj < 4; ++nj) {
                    const int col = cb + nj * 32 + l31;
#pragma unroll
                    for (int reg = 0; reg < 16; ++reg) {
                        const int row = rbase + mi * 32 + 8 * (reg >> 2) + (reg & 3);
                        Z[(size_t)row * ZE_LD + col] = f2bf(acc[mi][nj][reg]);
                    }
                }
        }
    }
}

__device__ __forceinline__ void phase_inproj_odd(const Params& p, int j, unsigned char* lds0, int hb, int wv) {
    const bf16_t* H = (const bf16_t*)(p.ws + OFF_B);
    const bf16_t* Wt = (const bf16_t*)(p.ws + OFF_W) + W_IN_C + (size_t)j * 4194304;
    bf16_t* Z = (bf16_t*)(p.ws + OFF_Z);
    bf16_t* VT = (bf16_t*)(p.ws + OFF_Z + ZO_VT);
    const int t512 = t512x();
    for (int it = 0;; ++it) {
        int mt, nt;
        if (!tile256_in(it, 16, mt, nt)) break;
        const int m0 = mt * 256, n0 = nt * 256;
        const bf16_t* Hm = H + (size_t)m0 * 1024;
        const bf16_t* Wn = Wt + (size_t)n0 * 1024;
        auto al = [&](int r, int k) { return Hm + (unsigned)(r * 1024 + k); };
        auto bl = [&](int r, int k) { return Wn + (unsigned)(r * 1024 + k); };
        f32x16 acc[2][4];
        zero_acc256(acc);
        gemm256_kloop(acc, al, bl, 16, lds0, t512);
        int tq = t512;
        asm volatile("" : "+v"(tq));
        const int lane = tq & 63, wm = wv >> 1, wn = wv & 1, l31 = lane & 31, half = lane >> 5;
        const int cw = n0 + wn * 128;
        const int seg = cw >> 10;
        if (seg == 2) {
            const int bb = m0 / SEQL, p0 = m0 % SEQL;
            const unsigned lo = (unsigned)(l31 * SEQL + 4 * half);
#pragma unroll
            for (int mi = 0; mi < 2; ++mi)
#pragma unroll
                for (int nj = 0; nj < 4; ++nj) {
                    bf16_t* vb = VT + ((size_t)bb * 1024 + (cw - 2048 + nj * 32)) * SEQL + p0 + wm * 64 + mi * 32;
#pragma unroll
                    for (int q4 = 0; q4 < 4; ++q4)
                        st4(vb + 8 * q4 + lo, acc[mi][nj][4 * q4], acc[mi][nj][4 * q4 + 1], acc[mi][nj][4 * q4 + 2], acc[mi][nj][4 * q4 + 3]);
                }
        } else {
            const float sc = (seg == 0) ? 0.125f : 1.f;
            const int cbase = (seg == 3) ? cw - 1024 : cw;
            const unsigned lo = (unsigned)(4 * half * ZO_LD + l31);
#pragma unroll
            for (int mi = 0; mi < 2; ++mi)
#pragma unroll
                for (int nj = 0; nj < 4; ++nj)
#pragma unroll
                    for (int reg = 0; reg < 16; ++reg) {
                        bf16_t* zb = Z + (size_t)(m0 + ROWU(mi, reg)) * ZO_LD + cbase + nj * 32;
                        zb[lo] = f2bf(acc[mi][nj][reg] * sc);
                    }
        }
    }
}

__device__ __forceinline__ void phase_outproj(const Params& p, int L, unsigned char* lds0, int hb, int wv) {
    const int j = L >> 1;
    const bool even = (L & 1) == 0;
    const bf16_t* Z = (const bf16_t*)(p.ws + OFF_Z);
    const bf16_t* Wt = (const bf16_t*)(p.ws + OFF_W) + (even ? W_OUT_AB : W_OUT_C) + (size_t)j * 1048576;
    bf16_t* Y = (bf16_t*)(p.ws + OFF_B);
    const bf16_t* OBp = (const bf16_t*)(p.ws + OFF_Z + ZE_US);
    const int ld = even ? ZE_LD : ZO_LD;
    const int t512 = t512x();
    for (int it = 0;; ++it) {
        int mt, nt;
        if (!tile256(it, 4, 384 * 4, mt, nt)) break;
        const int m0 = mt * 256, n0 = nt * 256;
        const bf16_t* OBm = OBp + (size_t)m0 * 512;
        const bf16_t* Zm = Z + (size_t)m0 * ld;
        const bf16_t* Wn = Wt + (size_t)n0 * 1024;
        auto al = [&](int r, int k) {
            if (even && k >= 512) return OBm + (unsigned)(r * 512 + (k - 512));
            return Zm + (unsigned)(r * ld + k);
        };
        auto bl = [&](int r, int k) { return Wn + (unsigned)(r * 1024 + k); };
        f32x16 acc[2][4];
        zero_acc256(acc);
        gemm256_kloop(acc, al, bl, 16, lds0, t512);
        int tq = t512;
        asm volatile("" : "+v"(tq));
        const int lane = tq & 63, wm = wv >> 1, wn = wv & 1, l31 = lane & 31, half = lane >> 5;
        {
            const unsigned lo = (unsigned)(4 * half * 1024 + l31);
#pragma unroll
            for (int mi = 0; mi < 2; ++mi)
#pragma unroll
                for (int nj = 0; nj < 4; ++nj)
#pragma unroll
                    for (int reg = 0; reg < 16; ++reg) {
                        bf16_t* yb = Y + (size_t)(m0 + ROWU(mi, reg)) * 1024 + n0 + wn * 128 + nj * 32;
                        yb[lo] = f2bf(acc[mi][nj][reg]);
                    }
        }
    }
}

__device__ __forceinline__ void cpow(float zre, float zim, float k, float& pr, float& pi) {
    const float mag = expf(k * zre);
    float s, c;
    sincosf(k * zim, &s, &c);
    pr = mag * c; pi = mag * s;
}

__device__ __forceinline__ void phase_s5consts(const Params& p, int j, unsigned char* lds, int hb, int wv) {
    bf16_t* KMAT = (bf16_t*)(p.ws + OFF_B + B_KMAT);
    bf16_t* EMAT = (bf16_t*)(p.ws + OFF_B + B_EMAT);
    float* sz = (float*)lds;
    float* sg = (float*)(lds + 4096);
    const int tid = tidx();
    const int NA_ = 32 * 8, NB_ = 32 * 8, NC_ = 32 * 8;
    for (int t = VB; t < NA_ + NB_ + NC_; t += VG) {
        int g, sub, type;
        if (t < NA_) { type = 0; g = t >> 3; sub = t & 7; }
        else if (t < NA_ + NB_) { type = 1; g = (t - NA_) >> 3; sub = (t - NA_) & 7; }
        else { type = 2; g = (t - NA_ - NB_) >> 3; sub = (t - NA_ - NB_) & 7; }
        __syncthreads();
        if (tid < 128) {
            const int dir = tid >> 6, pp = tid & 63;
            const size_t base = ((size_t)(j * 2 + dir) * 32 + g);
            const float delta = expf(p.log_step[base]);
            const float are = p.a_re[base * 64 + pp], aim = p.a_im[base * 64 + pp];
            const float zre = are * delta, zim = aim * delta;
            float abr, abi;
            cpow(zre, zim, 1.f, abr, abi);
            const float den = are * are + aim * aim;
            const float nre = abr - 1.f, nim = abi;
            sz[tid * 4 + 0] = zre; sz[tid * 4 + 1] = zim;
            sz[tid * 4 + 2] = (nre * are + nim * aim) / den;
            sz[tid * 4 + 3] = (nim * are - nre * aim) / den;
        }
        __syncthreads();
        if (type == 0) {
            const int tau0 = sub * 8;
            bf16_t* Kt = (bf16_t*)(lds + 16384);
            const int o = tid >> 4, i = tid & 15;
#pragma unroll 1
            for (int dir = 0; dir < 2; ++dir) {
                const int kmax = dir == 0 ? tau0 + 7 : 63 - tau0;
                const size_t base = ((size_t)(j * 2 + dir) * 32 + g);
                float* scb = (float*)(lds + 53248);
                __syncthreads();
                for (int e = tid; e < 1024; e += 256) {
                    scb[e] = p.c_re[base * 1024 + e];
                    scb[1024 + e] = p.c_im[base * 1024 + e];
                    scb[2048 + e] = p.b_re[base * 1024 + e];
                    scb[3072 + e] = p.b_im[base * 1024 + e];
                }
                const float* cre = scb + o * 64;
                const float* cim = scb + 1024 + o * 64;
                const float* bre = scb + 2048 + i;
                const float* bim = scb + 3072 + i;
#pragma unroll 1
                for (int k0 = 0; k0 <= kmax; k0 += 16) {
                    __syncthreads();
                    for (int e = tid; e < 16 * 64; e += 256) {
                        const int dd = e >> 6, pp = e & 63;
                        float pr, pi;
                        cpow(sz[(dir * 64 + pp) * 4], sz[(dir * 64 + pp) * 4 + 1], (float)(k0 + dd), pr, pi);
                        const float fr = sz[(dir * 64 + pp) * 4 + 2], fi = sz[(dir * 64 + pp) * 4 + 3];
                        sg[e * 2] = pr * fr - pi * fi;
                        sg[e * 2 + 1] = pr * fi + pi * fr;
                    }
                    __syncthreads();
                    float acc[16];
#pragma unroll
                    for (int dd = 0; dd < 16; ++dd) acc[dd] = 0.f;
                    for (int pp = 0; pp < 64; ++pp) {
                        const float cr = cre[pp], ci = cim[pp], br = bre[pp * 16], bi = bim[pp * 16];
                        const float wr = cr * br - ci * bi, wi = cr * bi + ci * br;
#pragma unroll
                        for (int dd = 0; dd < 16; ++dd) { const float2 gg = *(const float2*)(sg + (dd * 64 + pp) * 2); acc[dd] += gg.x * wr - gg.y * wi; }
                    }
#pragma unroll
                    for (int dd = 0; dd < 16; ++dd) {
                        const int k = k0 + dd;
                        if (k <= kmax) {
                            const int didx = (dir == 0 ? k : -k) - (tau0 - 63);
                            float v = acc[dd];
                            if (dir == 1 && k == 0) v += bf2f(Kt[didx * 256 + tid]);
                            Kt[didx * 256 + tid] = f2bf(v);
                        }
                    }
                }
            }
            __syncthreads();
            bf16_t* km = KMAT + (size_t)g * 1024 * 1280;
            for (int v = tid; v < 128 * 128; v += 256) {
                const int rowl = v >> 7, vv = v & 127;
                const int tau = tau0 + (rowl >> 4), oo = rowl & 15, s = vv >> 1, ih = vv & 1;
                const int didx = tau - s - (tau0 - 63);
                const uint4 val = *(const uint4*)(Kt + didx * 256 + oo * 16 + ih * 8);
                *(uint4*)(km + (size_t)(tau * 16 + oo) * 1280 + s * 16 + ih * 8) = val;
            }
        } else if (type == 1) {
            const int dir = tid >> 7, ri = (tid >> 6) & 1, pp = tid & 63;
            const size_t base = ((size_t)(j * 2 + dir) * 32 + g);
            bf16_t* km = KMAT + (size_t)g * 1024 * 1280;
            float cra[16], cia[16];
#pragma unroll
            for (int o = 0; o < 16; ++o) { cra[o] = p.c_re[(base * 16 + o) * 64 + pp]; cia[o] = p.c_im[(base * 16 + o) * 64 + pp]; }
#pragma unroll 1
            for (int u = 0; u < 8; ++u) {
                const int tau = sub * 8 + u;
                float pr, pi;
                const float kk = dir == 0 ? (float)(tau + 1) : (float)(64 - tau);
                cpow(sz[(dir * 64 + pp) * 4], sz[(dir * 64 + pp) * 4 + 1], kk, pr, pi);
#pragma unroll
                for (int o = 0; o < 16; ++o) {
                    const float cr = cra[o], ci = cia[o];
                    const float wr = cr * pr - ci * pi, wi = cr * pi + ci * pr;
                    km[(size_t)(tau * 16 + o) * 1280 + 1024 + tid] = f2bf(ri == 0 ? wr : -wi);
                }
            }
        } else {
            const int dir = tid >> 7, ri = (tid >> 6) & 1, pp = tid & 63;
            const float fr = sz[(dir * 64 + pp) * 4 + 2], fi = sz[(dir * 64 + pp) * 4 + 3];
            const size_t base = ((size_t)(j * 2 + dir) * 32 + g);
            const float* bre = p.b_re + (base * 64 + pp) * 16;
            const float* bim = p.b_im + (base * 64 + pp) * 16;
            float bra[16], bia[16];
#pragma unroll
            for (int i = 0; i < 16; ++i) { bra[i] = bre[i]; bia[i] = bim[i]; }
#pragma unroll 1
            for (int u = 0; u < 8; ++u) {
                const int s = sub * 8 + u;
                float pr, pi;
                const float kk = dir == 0 ? (float)(63 - s) : (float)s;
                cpow(sz[(dir * 64 + pp) * 4], sz[(dir * 64 + pp) * 4 + 1], kk, pr, pi);
                const float gr = pr * fr - pi * fi, gi = pr * fi + pi * fr;
                float v[16];
#pragma unroll
                for (int i = 0; i < 16; ++i) {
                    const float br = bra[i], bi = bia[i];
                    v[i] = ri == 0 ? (gr * br - gi * bi) : (gr * bi + gi * br);
                }
                uint4 o0, o1;
                o0.x = pk2(v[0], v[1]); o0.y = pk2(v[2], v[3]); o0.z = pk2(v[4], v[5]); o0.w = pk2(v[6], v[7]);
                o1.x = pk2(v[8], v[9]); o1.y = pk2(v[10], v[11]); o1.z = pk2(v[12], v[13]); o1.w = pk2(v[14], v[15]);
                bf16_t* em = EMAT + ((size_t)g * 256 + tid) * 1024 + s * 16;
                *(uint4*)em = o0;
                *(uint4*)(em + 8) = o1;
            }
        }
    }
}

__device__ __forceinline__ void phase_s5A(const Params& p, unsigned char* lds0, int hb, int wv) {
    const bf16_t* US = (const bf16_t*)(p.ws + OFF_Z + ZE_US);
    const bf16_t* EMAT = (const bf16_t*)(p.ws + OFF_B + B_EMAT);
    float* E = (float*)(p.ws + OFF_Z + ZE_E);
    const int t512 = t512x();
    for (int t = blockIdx.x; t < 32 * 6; t += gridDim.x) {
        const int g = t / 6, mt = t % 6, m0 = mt * 256;
        const bf16_t* USg = US + ((size_t)m0 * 32 + g) * 1024;
        const bf16_t* EMg = EMAT + (size_t)g * 256 * 1024;
        auto al = [&](int r, int k) { return USg + (unsigned)(r * 32768 + k); };
        auto bl = [&](int r, int k) { return EMg + (unsigned)(r * 1024 + k); };
        f32x16 acc[2][4];
        zero_acc256(acc);
        gemm256_kloop(acc, al, bl, 16, lds0, t512);
        int tq = t512;
        asm volatile("" : "+v"(tq));
        const int lane = tq & 63, wm = wv >> 1, wn = wv & 1, l31 = lane & 31, half = lane >> 5;
        const unsigned lo = (unsigned)(4 * half * 8192 + l31);
#pragma unroll
        for (int mi = 0; mi < 2; ++mi)
#pragma unroll
            for (int nj = 0; nj < 4; ++nj)
#pragma unroll
                for (int reg = 0; reg < 16; ++reg) {
                    float* eb = E + ((size_t)(m0 + ROWU(mi, reg)) * 32 + g) * 256 + wn * 128 + nj * 32;
                    eb[lo] = acc[mi][nj][reg];
                }
    }
}

__device__ __forceinline__ void phase_s5scan(const Params& p, int j, int hb, int wv) {
    const float* E = (const float*)(p.ws + OFF_Z + ZE_E);
    bf16_t* CARRY = (bf16_t*)(p.ws + OFF_Z + ZE_CARRY);
    for (int it = VB * 256 + tidx(); it < 12 * 32 * 2 * 64; it += VG * 256) {
        const int pp = it & 63, dir = (it >> 6) & 1, g = (it >> 7) & 31, b = it >> 12;
        const size_t base = ((size_t)(j * 2 + dir) * 32 + g);
        const float delta = expf(p.log_step[base]);
        const float zre = p.a_re[base * 64 + pp] * delta, zim = p.a_im[base * 64 + pp] * delta;
        float ar, ai;
        cpow(zre, zim, 64.f, ar, ai);
        float fr = 0.f, fi = 0.f;
#pragma unroll 1
        for (int s0 = 0; s0 < 128; s0 += 32) {
            float er[32], ei[32];
#pragma unroll
            for (int u = 0; u < 32; ++u) {
                const int n = dir == 0 ? (s0 + u) : 127 - (s0 + u);
                const size_t idx = ((size_t)(b * 128 + n) * 32 + g) * 256 + dir * 128 + pp;
                er[u] = E[idx]; ei[u] = E[idx + 64];
            }
#pragma unroll
            for (int u = 0; u < 32; ++u) {
                const int n = dir == 0 ? (s0 + u) : 127 - (s0 + u);
                const size_t idx = ((size_t)(b * 128 + n) * 32 + g) * 256 + dir * 128 + pp;
                CARRY[idx] = f2bf(fr);
                CARRY[idx + 64] = f2bf(fi);
                const float nr = ar * fr - ai * fi + er[u];
                const float ni = ar * fi + ai * fr + ei[u];
                fr = nr; fi = ni;
            }
        }
    }
}

__device__ __forceinline__ void phase_s5main(const Params& p, int j, unsigned char* lds0, int hb, int wv) {
    const bf16_t* US = (const bf16_t*)(p.ws + OFF_Z + ZE_US);
    const bf16_t* KMAT = (const bf16_t*)(p.ws + OFF_B + B_KMAT);
    const bf16_t* CARRY = (const bf16_t*)(p.ws + OFF_Z + ZE_CARRY);
    bf16_t* YG = (bf16_t*)(p.ws + OFF_B + B_YG);
    const int t512 = t512x();
    for (int t = blockIdx.x; t < 32 * 6 * 4; t += gridDim.x) {
        const int g = t / 24, mt = (t % 24) >> 2, nt = t & 3, m0 = mt * 256, n0 = nt * 256;
        const bf16_t* USg = US + ((size_t)m0 * 32 + g) * 1024;
        const bf16_t* CAg = CARRY + ((size_t)m0 * 32 + g) * 256;
        const bf16_t* KMg = KMAT + ((size_t)g * 1024 + n0) * 1280;
        auto al = [&](int r, int k) {
            if (k < 1024) return USg + (unsigned)(r * 32768 + k);
            return CAg + (unsigned)(r * 8192 + (k - 1024));
        };
        auto bl = [&](int r, int k) { return KMg + (unsigned)(r * 1280 + k); };
        f32x16 acc[2][4];
        zero_acc256(acc);
        gemm256_kloop(acc, al, bl, 20, lds0, t512);
        int tq = t512;
        asm volatile("" : "+v"(tq));
        const int lane = tq & 63, wm = wv >> 1, wn = wv & 1, l31 = lane & 31, half = lane >> 5;
        {
            const unsigned loU = (unsigned)(4 * half * 32768 + l31);
            const unsigned loY = (unsigned)(4 * half * 32768 + (l31 >> 4) * 512 + (l31 & 15));
            const float dsk = p.ssm_d[(size_t)j * 512 + g * 16 + (l31 & 15)];
            bf16_t uv[2][8];
#define S5_LOAD(Q, BUF) { const int mi_ = (Q) >> 3, nj_ = ((Q) >> 1) & 3, hq_ = (Q) & 1; const int nb_ = n0 + wn * 128 + nj_ * 32; \
            _Pragma("unroll") for (int r8 = 0; r8 < 8; ++r8) { const int reg = hq_ * 8 + r8; \
                uv[BUF][r8] = (US + ((size_t)(m0 + ROWU(mi_, reg)) * 32 + g) * 1024 + nb_)[loU]; } }
            S5_LOAD(0, 0);
#pragma unroll
            for (int q = 0; q < 16; ++q) {
                if (q + 1 < 16) S5_LOAD(q + 1, (q + 1) & 1);
                const int mi = q >> 3, nj = (q >> 1) & 3, hq = q & 1;
                const int nb = n0 + wn * 128 + nj * 32;
#pragma unroll
                for (int r8 = 0; r8 < 8; ++r8) {
                    const int reg = hq * 8 + r8;
                    bf16_t* yb = YG + ((size_t)(m0 + ROWU(mi, reg)) * 64 + (nb >> 4)) * 512 + g * 16;
                    yb[loY] = f2bf(gelu_tanh(acc[mi][nj][reg] + dsk * bf2f(uv[q & 1][r8])));
                }
            }
#undef S5_LOAD
        }
    }
}

__device__ __forceinline__ void phase_glu(const Params& p, int j, unsigned char* lds0, int hb, int wv) {
    const bf16_t* Z = (const bf16_t*)(p.ws + OFF_Z);
    bf16_t* OBp = (bf16_t*)(p.ws + OFF_Z + ZE_US);
    const bf16_t* YG = (const bf16_t*)(p.ws + OFF_B + B_YG);
    const bf16_t* Wt = (const bf16_t*)(p.ws + OFF_W) + W_GLU + (size_t)j * 262144;
    const int t512 = t512x();
    for (int t = blockIdx.x; t < 384 * 2; t += gridDim.x) {
        const int mt = t >> 1, nt = t & 1, m0 = mt * 256, n0 = nt * 256;
        const bf16_t* YGm = YG + (size_t)m0 * 512;
        const bf16_t* Wn = Wt + (size_t)n0 * 512;
        auto al = [&](int r, int k) { return YGm + (unsigned)(r * 512 + k); };
        auto bl = [&](int r, int k) { return Wn + (unsigned)(r * 512 + k); };
        f32x16 acc[2][4];
        zero_acc256(acc);
        gemm256_kloop(acc, al, bl, 8, lds0, t512);
        int tq = t512;
        asm volatile("" : "+v"(tq));
        const int lane = tq & 63, wm = wv >> 1, wn = wv & 1, l31 = lane & 31, half = lane >> 5;
        {
            const unsigned loY = (unsigned)(4 * half * 512 + l31), loZ = (unsigned)(4 * half * ZE_LD + l31);
            bf16_t yv[2][8], gv[2][8];
#define GLU_LOAD(Q, BUF) { const int mi_ = (Q) >> 3, nj_ = ((Q) >> 1) & 3, hq_ = (Q) & 1; const int cb_ = n0 + wn * 128 + nj_ * 32; \
            _Pragma("unroll") for (int r8 = 0; r8 < 8; ++r8) { const int reg = hq_ * 8 + r8; \
                yv[BUF][r8] = (YG + (size_t)(m0 + ROWU(mi_, reg)) * 512 + cb_)[loY]; \
                gv[BUF][r8] = (Z + (size_t)(m0 + ROWU(mi_, reg)) * ZE_LD + 1536 + cb_)[loZ]; } }
            GLU_LOAD(0, 0);
#pragma unroll
            for (int q = 0; q < 16; ++q) {
                if (q + 1 < 16) GLU_LOAD(q + 1, (q + 1) & 1);
                const int mi = q >> 3, nj = (q >> 1) & 3, hq = q & 1;
                const int cb = n0 + wn * 128 + nj * 32;
#pragma unroll
                for (int r8 = 0; r8 < 8; ++r8) {
                    const int reg = hq * 8 + r8;
                    (OBp + (size_t)(m0 + ROWU(mi, reg)) * 512 + cb)[loY] = f2bf(bf2f(yv[q & 1][r8]) * sigmoidf_(acc[mi][nj][reg]) * siluf_(bf2f(gv[q & 1][r8])));
                }
            }
#undef GLU_LOAD
        }
    }
}

__device__ __forceinline__ void phase_ret1(const Params& p, unsigned char* lds, int hb, int wv) {
    const bf16_t* VT = (const bf16_t*)(p.ws + OFF_Z + ZE_VT);
    const bf16_t* KT = (const bf16_t*)(p.ws + OFF_Z + ZE_KT);
    bf16_t* ST = (bf16_t*)(p.ws + OFF_B);
    const int tid = tidx();
    const int lane = tid & 63, wave = tid >> 6, wm = wave >> 1, wn = wave & 1, l31 = lane & 31, half = lane >> 5;
    for (int t = VB; t < 2 * 3072; t += VG) {
        const int dir = t / 3072, r3 = t % 3072, b = r3 / 256, n = (r3 >> 2) & 63, h = r3 & 3;
        const float l2g = log2_gamma(h);
        const bf16_t* vt = VT + ((size_t)(b * 4 + h) * 128) * SEQL + n * 128;
        const bf16_t* kt = KT + ((size_t)(b * 4 + h) * 128) * SEQL + n * 128;
        auto al = [&](int r, int k) {
            const uint4 v = *(const uint4*)(vt + (size_t)r * SEQL + k);
            float w[8];
#pragma unroll
            for (int e = 0; e < 8; ++e) w[e] = __builtin_amdgcn_exp2f(l2g * (dir == 0 ? (float)(128 - (k + e)) : (float)(k + e + 1)));
            uint4 o;
            o.x = pk2(__uint_as_float(v.x << 16) * w[0], __uint_as_float(v.x & 0xffff0000u) * w[1]);
            o.y = pk2(__uint_as_float(v.y << 16) * w[2], __uint_as_float(v.y & 0xffff0000u) * w[3]);
            o.z = pk2(__uint_as_float(v.z << 16) * w[4], __uint_as_float(v.z & 0xffff0000u) * w[5]);
            o.w = pk2(__uint_as_float(v.w << 16) * w[6], __uint_as_float(v.w & 0xffff0000u) * w[7]);
            return o;
        };
        auto bl = [&](int r, int k) { return *(const uint4*)(kt + (size_t)r * SEQL + k); };
        f32x16 acc[2][2];
        zero_acc(acc);
        gemm_kloop(acc, al, bl, 2, lds, tid);
        bf16_t* st = ST + ((((size_t)dir * 12 + b) * 64 + n) * 4 + h) * 16384;
#pragma unroll
        for (int mi = 0; mi < 2; ++mi) {
            const int e = wm * 64 + mi * 32 + l31;
#pragma unroll
            for (int nj = 0; nj < 2; ++nj)
#pragma unroll
                for (int q4 = 0; q4 < 4; ++q4) {
                    const int d = wn * 32 + nj * 64 + 8 * q4 + 4 * half;
                    st4(st + e * 128 + d, acc[mi][nj][4 * q4], acc[mi][nj][4 * q4 + 1], acc[mi][nj][4 * q4 + 2], acc[mi][nj][4 * q4 + 3]);
                }
        }
    }
}

__device__ __forceinline__ void phase_ret2(const Params& p, int hb, int wv) {
    bf16_t* ST = (bf16_t*)(p.ws + OFF_B);
    for (int it = VB * 256 + tidx(); it < 2 * 12 * 4 * 2048; it += VG * 256) {
        const int v = it & 2047, h = (it >> 11) & 3, bd = it >> 13;
        const int dir = bd / 12;
        const float dec = exp2f(128.f * log2_gamma(h));
        float c[8];
#pragma unroll
        for (int e = 0; e < 8; ++e) c[e] = 0.f;
#pragma unroll 1
        for (int s0 = 0; s0 < 64; s0 += 16) {
            uint4 kvv[16];
#pragma unroll
            for (int u = 0; u < 16; ++u) {
                const int n = dir == 0 ? (s0 + u) : 63 - (s0 + u);
                kvv[u] = *(const uint4*)(ST + (((size_t)bd * 64 + n) * 4 + h) * 16384 + v * 8);
            }
#pragma unroll
            for (int u = 0; u < 16; ++u) {
                const int n = dir == 0 ? (s0 + u) : 63 - (s0 + u);
                bf16_t* ptr = ST + (((size_t)bd * 64 + n) * 4 + h) * 16384 + v * 8;
                const uint4 kv = kvv[u];
                uint4 o;
                o.x = pk2(c[0], c[1]); o.y = pk2(c[2], c[3]); o.z = pk2(c[4], c[5]); o.w = pk2(c[6], c[7]);
                *(uint4*)ptr = o;
                c[0] = dec * c[0] + __uint_as_float(kv.x << 16); c[1] = dec * c[1] + __uint_as_float(kv.x & 0xffff0000u);
                c[2] = dec * c[2] + __uint_as_float(kv.y << 16); c[3] = dec * c[3] + __uint_as_float(kv.y & 0xffff0000u);
                c[4] = dec * c[4] + __uint_as_float(kv.z << 16); c[5] = dec * c[5] + __uint_as_float(kv.z & 0xffff0000u);
                c[6] = dec * c[6] + __uint_as_float(kv.w << 16); c[7] = dec * c[7] + __uint_as_float(kv.w & 0xffff0000u);
            }
        }
    }
}

__device__ __forceinline__ void phase_ret3(const Params& p, unsigned char* lds, int hb, int wv) {
    bf16_t* Z = (bf16_t*)(p.ws + OFF_Z);
    const bf16_t* VT = (const bf16_t*)(p.ws + OFF_Z + ZE_VT);
    const bf16_t* ST = (const bf16_t*)(p.ws + OFF_B);
    float2* stat = (float2*)(lds + 4 * STAGE_B);
    const int tid = tidx();
    const int lane = tid & 63, wave = tid >> 6, wm = wave >> 1, wn = wave & 1, l31 = lane & 31, half = lane >> 5;
    for (int t = VB; t < 3072; t += VG) {
        const int b = t / 256, n = (t >> 2) & 63, h = t & 3;
        const float l2g = log2_gamma(h);
        const size_t m0 = (size_t)b * SEQL + n * 128;
        const bf16_t* zq = Z + m0 * ZE_LD + h * 128;
        const bf16_t* zk = Z + m0 * ZE_LD + 512 + h * 128;
        const bf16_t* stf = ST + ((((size_t)0 * 12 + b) * 64 + n) * 4 + h) * 16384;
        const bf16_t* stb = ST + ((((size_t)1 * 12 + b) * 64 + n) * 4 + h) * 16384;
        const bf16_t* vt = VT + ((size_t)(b * 4 + h) * 128) * SEQL + n * 128;
        f32x16 acc[2][2], accS[2][2];
        zero_acc(accS);
        {
            auto al = [&](int r, int k) { return *(const uint4*)(zq + (size_t)r * ZE_LD + k); };
            auto bl = [&](int r, int k) { return *(const uint4*)(zk + (size_t)r * ZE_LD + k); };
            gemm_kloop1(accS, al, bl, 2, lds, tid);
        }
        float l2gp = l2g;
        asm volatile("" : "+v"(l2gp));
        int l31p = l31;
        asm volatile("" : "+v"(l31p));
#pragma unroll
        for (int mi = 0; mi < 2; ++mi) {
            const int i = wm * 64 + mi * 32 + l31p;
#pragma unroll
            for (int nj = 0; nj < 2; ++nj)
#pragma unroll
                for (int q4 = 0; q4 < 4; ++q4) {
                    const int jj = wn * 32 + nj * 64 + 8 * q4 + 4 * half;
                    float pv[4];
#pragma unroll
                    for (int r = 0; r < 4; ++r) {
                        const int dj = i - (jj + r);
                        pv[r] = accS[mi][nj][4 * q4 + r] * __builtin_amdgcn_exp2f(l2gp * (float)(dj < 0 ? -dj : dj));
                    }
                    uint2 o; o.x = pk2(pv[0], pv[1]); o.y = pk2(pv[2], pv[3]);
                    *(uint2*)(lds + (jj >> 6) * STAGE_B + i * LDS_PITCH + (jj & 63) * 2) = o;
                }
        }
        __builtin_amdgcn_sched_barrier(0);
        {
            const int srow = tid >> 3, skc = (tid & 7) * 8;
#pragma unroll
            for (int kt = 0; kt < 2; ++kt) {
                uint4 v[4];
#pragma unroll
                for (int i = 0; i < 4; ++i) v[i] = *(const uint4*)(vt + (size_t)(srow + 32 * i) * SEQL + kt * 64 + skc);
#pragma unroll
                for (int i = 0; i < 4; ++i) *(uint4*)(lds + 2 * STAGE_B + kt * STAGE_B + (srow + 32 * i) * LDS_PITCH + skc * 2) = v[i];
                __builtin_amdgcn_sched_barrier(0);
            }
        }
        __syncthreads();
        zero_acc(acc);
        compute_ktile(acc, lds, lds + 2 * STAGE_B, tid, true);
        compute_ktile(acc, lds + STAGE_B, lds + 3 * STAGE_B, tid, true);
#pragma unroll 1
        for (int dirsel = 0; dirsel < 2; ++dirsel) {
            const bf16_t* stp = dirsel == 0 ? stf : stb;
            auto al = [&](int r, int k) {
                const uint4 v = *(const uint4*)(zq + (size_t)r * ZE_LD + k);
                const float s = __builtin_amdgcn_exp2f(l2g * (dirsel == 0 ? (float)r : (float)(127 - r)));
                return scale8(v, s);
            };
            auto bl = [&](int r, int k) { return *(const uint4*)(stp + r * 128 + k); };
            gemm_kloop1(acc, al, bl, 2, lds, tid);
        }
        float s1[2], s2[2];
#pragma unroll
        for (int mi = 0; mi < 2; ++mi) {
            float a = 0.f, q = 0.f;
#pragma unroll
            for (int nj = 0; nj < 2; ++nj)
#pragma unroll
                for (int e = 0; e < 16; ++e) { const float v = acc[mi][nj][e]; a += v; q += v * v; }
            a += __shfl_xor(a, 32); q += __shfl_xor(q, 32);
            s1[mi] = a; s2[mi] = q;
            if (half == 0) stat[(wm * 64 + mi * 32 + l31) * 2 + wn] = make_float2(a, q);
        }
        __syncthreads();
#pragma unroll
        for (int mi = 0; mi < 2; ++mi) {
            const int i = wm * 64 + mi * 32 + l31;
            const float2 o = stat[i * 2 + (wn ^ 1)];
            const float mean = (s1[mi] + o.x) * (1.f / 128.f);
            const float var = (s2[mi] + o.y) * (1.f / 128.f) - mean * mean;
            const float rstd = rsqrtf(fmaxf(var, 0.f) + EPSF);
            bf16_t* zr = Z + (m0 + i) * ZE_LD;
            float gg[2][4][4];
#pragma unroll
            for (int nj = 0; nj < 2; ++nj)
#pragma unroll
                for (int q4 = 0; q4 < 4; ++q4) {
                    const int e = wn * 32 + nj * 64 + 8 * q4 + 4 * half;
                    ld4(zr + 1024 + h * 128 + e, gg[nj][q4][0], gg[nj][q4][1], gg[nj][q4][2], gg[nj][q4][3]);
                }
#pragma unroll
            for (int nj = 0; nj < 2; ++nj)
#pragma unroll
                for (int q4 = 0; q4 < 4; ++q4) {
                    const int e = wn * 32 + nj * 64 + 8 * q4 + 4 * half;
                    st4(zr + h * 128 + e,
                        (acc[mi][nj][4 * q4] - mean) * rstd * siluf_(gg[nj][q4][0]), (acc[mi][nj][4 * q4 + 1] - mean) * rstd * siluf_(gg[nj][q4][1]),
                        (acc[mi][nj][4 * q4 + 2] - mean) * rstd * siluf_(gg[nj][q4][2]), (acc[mi][nj][4 * q4 + 3] - mean) * rstd * siluf_(gg[nj][q4][3]));
                }
        }
        __syncthreads();
    }
}

__device__ __forceinline__ void phase_na(const Params& p, int j, unsigned char* lds, int hb, int wv) {
    bf16_t* Z = (bf16_t*)(p.ws + OFF_Z);
    const bf16_t* VT = (const bf16_t*)(p.ws + OFF_Z + ZO_VT);
    float* btab = (float*)(lds + 4 * STAGE_B);
    const int tid = tidx();
    const int lane = tid & 63, a = tid >> 6;
    const int l15 = lane & 15, g = lane >> 4;
    const int kw = (a == 0) ? 0 : (a == 1) ? 8 : (a == 2) ? 24 : 32;
    const int cq = a * 16 + l15;
    int cs = cq - 8; cs = cs < 0 ? 0 : (cs > 48 ? 48 : cs);
    const int srow = tid >> 3, sc8 = (tid & 7) * 8;
    const unsigned koff = (unsigned)(srow * ZO_LD + sc8), voff = (unsigned)(srow * SEQL + sc8);
    const bool xmap = (gridDim.x == 256);
    const int RPB = xmap ? 2 : 16;
    for (int it = 0;; ++it) {
        if (xmap && it >= 24) break;
        int bh, r0;
        if (xmap) { bh = it * 8 + (blockIdx.x & 7); r0 = ((blockIdx.x >> 3) * 2 + hb) * RPB; }
        else { const int c = it * VG + VB; if (c >= 192 * 8) break; bh = c >> 3; r0 = (c & 7) * 16; }
        const int b = bh >> 4, h = bh & 15;
        __syncthreads();
        for (int i = tid; i < 15 * 32; i += 256) {
            const int rr = i >> 5, cc = i & 31;
            btab[i] = cc < 31 ? p.rel_bias[(((size_t)j * 16 + h) * 15 + rr) * 31 + cc] : 0.f;
        }
        const bf16_t* vtb = VT + ((size_t)(b * 16 + h) * 64) * SEQL;
#pragma unroll 1
        for (int r = r0; r < r0 + RPB; ++r) {
            int rs = r - 4; rs = rs < 0 ? 0 : (rs > 120 ? 120 : rs);
            const size_t tokq = (size_t)b * SEQL + r * 64 + cq;
            bf16_t* zq = Z + tokq * ZO_LD + h * 64;
            u32x4 st[16];
            {
                const bf16_t* kbase = Z + ((size_t)b * SEQL + rs * 64) * ZO_LD + 1024 + h * 64;
#pragma unroll
                for (int i = 0; i < 16; ++i) st[i] = *(const u32x4*)(kbase + (size_t)(32 * i) * ZO_LD + koff);
            }
            const bf16x8 q0 = *(const bf16x8*)(zq + g * 8);
            const bf16x8 q1 = *(const bf16x8*)(zq + 32 + g * 8);
            __syncthreads();
#pragma unroll
            for (int i = 0; i < 16; ++i) *(u32x4*)(lds + (srow + 32 * i) * LDS_PITCH + sc8 * 2) = st[i];
            __syncthreads();
            f32x4 S[8][2];
#pragma unroll
            for (int kr = 0; kr < 8; ++kr) {
                const float* rbr = btab + (rs + kr - r + 7) * 32;
#pragma unroll
                for (int kb = 0; kb < 2; ++kb) {
                    const unsigned char* kp = lds + (kr * 64 + kw + kb * 16 + l15) * LDS_PITCH + g * 16;
                    const bf16x8 k0 = *(const bf16x8*)kp;
                    const bf16x8 k1 = *(const bf16x8*)(kp + 64);
                    f32x4 s = {0.f, 0.f, 0.f, 0.f};
                    s = __builtin_amdgcn_mfma_f32_16x16x32_bf16(k0, q0, s, 0, 0, 0);
                    s = __builtin_amdgcn_mfma_f32_16x16x32_bf16(k1, q1, s, 0, 0, 0);
#pragma unroll
                    for (int e = 0; e < 4; ++e) {
                        const int kc = kw + kb * 16 + 4 * g + e;
                        int dc = kc - cq + 15; dc = dc < 0 ? 0 : (dc > 30 ? 30 : dc);
                        const bool valid = (kc >= cs) && (kc < cs + 16);
                        s[e] = valid ? s[e] + rbr[dc] : -1e30f;
                    }
                    S[kr][kb] = s;
                }
            }
            u32x4 sv[16];
            const bf16_t* vbase = vtb + rs * 64;
#pragma unroll
            for (int i = 0; i < 8; ++i) {
                sv[i] = *(const u32x4*)(vbase + (size_t)(32 * (i & 1)) * SEQL + (i >> 1) * 64 + voff);
            }
            float mx = -1e30f;
#pragma unroll
            for (int kr = 0; kr < 8; ++kr)
#pragma unroll
                for (int kb = 0; kb < 2; ++kb)
#pragma unroll
                    for (int e = 0; e < 4; ++e) mx = fmaxf(mx, S[kr][kb][e]);
            mx = fmaxf(mx, __shfl_xor(mx, 16));
            mx = fmaxf(mx, __shfl_xor(mx, 32));
            float sum = 0.f;
            u32x4 P[8];
#pragma unroll
            for (int kr = 0; kr < 8; ++kr) {
                float ev[8];
#pragma unroll
                for (int kb = 0; kb < 2; ++kb)
#pragma unroll
                    for (int e = 0; e < 4; ++e) { ev[kb * 4 + e] = __expf(S[kr][kb][e] - mx); sum += ev[kb * 4 + e]; }
                P[kr].x = pk2(ev[0], ev[1]); P[kr].y = pk2(ev[2], ev[3]); P[kr].z = pk2(ev[4], ev[5]); P[kr].w = pk2(ev[6], ev[7]);
            }
#pragma unroll
            for (int i = 8; i < 16; ++i) {
                sv[i] = *(const u32x4*)(vbase + (size_t)(32 * (i & 1)) * SEQL + (i >> 1) * 64 + voff);
            }
            sum += __shfl_xor(sum, 16);
            sum += __shfl_xor(sum, 32);
            const float rinv = 1.f / sum;
            __syncthreads();
#pragma unroll
            for (int i = 0; i < 16; ++i) *(u32x4*)(lds + (srow + 32 * i) * LDS_PITCH + sc8 * 2) = sv[i];
            __syncthreads();
            f32x4 O[4];
#pragma unroll
            for (int blk = 0; blk < 4; ++blk) O[blk] = (f32x4){0.f, 0.f, 0.f, 0.f};
#pragma unroll
            for (int kr = 0; kr < 8; ++kr) {
                const bf16x8 pf = (bf16x8)P[kr];
#pragma unroll
                for (int blk = 0; blk < 4; ++blk) {
                    const unsigned char* vp = lds + (kr * 64 + blk * 16 + l15) * LDS_PITCH + (kw + 4 * g) * 2;
                    const uint2 lo = *(const uint2*)vp;
                    const uint2 hi = *(const uint2*)(vp + 32);
                    u32x4 vu; vu.x = lo.x; vu.y = lo.y; vu.z = hi.x; vu.w = hi.y;
                    O[blk] = __builtin_amdgcn_mfma_f32_16x16x32_bf16((bf16x8)vu, pf, O[blk], 0, 0, 0);
                }
            }
            const bf16_t* zg = Z + tokq * ZO_LD + 2048 + h * 64;
            float go[4][4];
#pragma unroll
            for (int blk = 0; blk < 4; ++blk) ld4(zg + blk * 16 + 4 * g, go[blk][0], go[blk][1], go[blk][2], go[blk][3]);
#pragma unroll
            for (int blk = 0; blk < 4; ++blk) {
                const int dh = blk * 16 + 4 * g;
                st4(zq + dh, O[blk][0] * rinv * siluf_(go[blk][0]), O[blk][1] * rinv * siluf_(go[blk][1]), O[blk][2] * rinv * siluf_(go[blk][2]), O[blk][3] * rinv * siluf_(go[blk][3]));
            }
        }
    }
}

constexpr int N_PHASES = 32;
__device__ __forceinline__ void run_phase(const Params& p, int ph, unsigned char* lds, unsigned char* lds0, int hb, int wv) {
    if (ph >= 100) return;
    if (ph == 0) { phase_prologue(p, lds, hb, wv); return; }
    if (ph == 31) { phase_norm(p, 4, hb, wv); return; }
    int q = ph - 1;
    const int pair = q / 15; q %= 15;
    if (q < 11) {
        const int L = pair * 2, j = pair;
        switch (q) {
            case 0: phase_norm(p, L, hb, wv); break;
            case 1: phase_inproj_even(p, j, lds0, hb, wv); break;
            case 2: phase_s5consts(p, j, lds, hb, wv); break;
            case 3: phase_s5A(p, lds0, hb, wv); break;
            case 4: phase_s5scan(p, j, hb, wv); break;
            case 5: phase_s5main(p, j, lds0, hb, wv); break;
            case 6: phase_glu(p, j, lds0, hb, wv); break;
            case 7: phase_ret1(p, lds, hb, wv); break;
            case 8: phase_ret2(p, hb, wv); break;
            case 9: phase_ret3(p, lds, hb, wv); break;
            default: phase_outproj(p, L, lds0, hb, wv); break;
        }
    } else {
        const int L = pair * 2 + 1, j = pair;
        switch (q - 11) {
            case 0: phase_norm(p, L, hb, wv); break;
            case 1: phase_inproj_odd(p, j, lds0, hb, wv); break;
            case 2: phase_na(p, j, lds, hb, wv); break;
            default: phase_outproj(p, L, lds0, hb, wv); break;
        }
    }
}

#ifndef PROBE_PH
#define PROBE_PH 0
#define PROBE_N 0
#endif
__device__ __forceinline__ void grid_barrier(unsigned* ctr, unsigned target, int wv) {
    asm volatile("s_waitcnt vmcnt(0)" ::: "memory");
    __syncthreads();
    if (wv == 0 && lane_id() == 0) {
        __builtin_amdgcn_fence(__ATOMIC_RELEASE, "agent");
        asm volatile("s_waitcnt vmcnt(0)" ::: "memory");
        __hip_atomic_fetch_add(ctr, 1u, __ATOMIC_RELAXED, __HIP_MEMORY_SCOPE_AGENT);
        while (__hip_atomic_load(ctr, __ATOMIC_RELAXED, __HIP_MEMORY_SCOPE_AGENT) < target) { }
        __builtin_amdgcn_fence(__ATOMIC_ACQUIRE, "agent");
        asm volatile("s_waitcnt vmcnt(0)" ::: "memory");
    }
    __syncthreads();
}

__global__ void __launch_bounds__(512, 2) fwd_megakernel(Params p_in, int n_extra, int probe_ph) {
    __shared__ __attribute__((aligned(16))) unsigned char lds_all[2 * LDS_TOTAL];
    const Params& p = p_in;
    const int wv = __builtin_amdgcn_readfirstlane((int)(threadIdx.x >> 6));
    const int hb = wv >> 2;
    unsigned char* lds = lds_all + hb * LDS_TOTAL;
    cg::grid_group grid = cg::this_grid();
    unsigned* bar = (unsigned*)(p.ws + OFF_BAR);
    if (blockIdx.x == 0 && threadIdx.x == 0) __hip_atomic_store(bar, 0u, __ATOMIC_RELAXED, __HIP_MEMORY_SCOPE_AGENT);
    const int total = N_PHASES + n_extra;
#pragma unroll 1
    for (int it = 0; it < total; ++it) {
        const int ph = it < N_PHASES ? it : probe_ph + (it - N_PHASES);
        run_phase(p, ph, lds, lds_all, hb, wv);
        if (it + 1 < total) {
            if (it == 0) grid.sync();
            else grid_barrier(bar, (unsigned)it * gridDim.x, wv);
        }
    }
}

extern "C" void kernel_launch(void* const* d_in, const int* in_sizes, int n_in, void* d_out, int out_size, void* d_ws, size_t ws_size,
                              hipStream_t stream) {
    static int grid_blocks = 0;
    if (!grid_blocks) {
        int dev = 0, cus = 0, per_cu = 0;
        hipGetDevice(&dev);
        hipDeviceGetAttribute(&cus, hipDeviceAttributeMultiprocessorCount, dev);
        hipOccupancyMaxActiveBlocksPerMultiprocessor(&per_cu, fwd_megakernel, 512, 0);
        if (per_cu < 1) per_cu = 1;
        if (per_cu > 1) per_cu = 1;
        grid_blocks = cus * per_cu;
    }
    Params p{};
    p.x_prompt = (const float*)d_in[0]; p.x_sample = (const float*)d_in[1]; p.c_prompt = (const float*)d_in[2]; p.c_sample = (const float*)d_in[3];
    p.norm_pre = (const float*)d_in[4]; p.norm_post = (const float*)d_in[5]; p.w_mod = (const float*)d_in[6]; p.b_mod = (const float*)d_in[7];
    p.w_in_ab = (const float*)d_in[8]; p.w_out_ab = (const float*)d_in[9]; p.a_re = (const float*)d_in[10]; p.a_im = (const float*)d_in[11];
    p.log_step = (const float*)d_in[12]; p.b_re = (const float*)d_in[13]; p.b_im = (const float*)d_in[14]; p.c_re = (const float*)d_in[15];
    p.c_im = (const float*)d_in[16]; p.ssm_d = (const float*)d_in[17]; p.w_glu = (const float*)d_in[18]; p.w_in_c = (const float*)d_in[19];
    p.w_out_c = (const float*)d_in[20]; p.rel_bias = (const float*)d_in[21];
    p.out = (float*)d_out; p.ws = (unsigned char*)d_ws;
    int n_extra = PROBE_N, probe_ph = PROBE_PH;
    void* args[] = {&p, &n_extra, &probe_ph};
    hipError_t e = hipLaunchCooperativeKernel((void*)fwd_megakernel, dim3(grid_blocks), dim3(512), args, 0, stream);
    if (e != hipSuccess) fprintf(stderr, "cooperative launch failed: %s (grid %d)\n", hipGetErrorString(e), grid_blocks);
}
```

```cpp
#include <hip/hip_runtime.h>
#include <hip/hip_cooperative_groups.h>
#include <cstdio>
#include <cstdint>
namespace cg = cooperative_groups;

typedef unsigned short bf16_t;
typedef short bf16x8 __attribute__((ext_vector_type(8)));
typedef float f32x4 __attribute__((ext_vector_type(4)));
typedef float f32x16 __attribute__((ext_vector_type(16)));
typedef unsigned u32x4 __attribute__((ext_vector_type(4)));

constexpr int T_TOK = 98304, SEQL = 8192, DM = 1024;
constexpr float EPSF = 1e-6f;

constexpr size_t OFF_Z = 0;
constexpr size_t SZ_Z = 805306368ull;
constexpr size_t OFF_B = OFF_Z + SZ_Z;
constexpr size_t SZ_B = 201326592ull;
constexpr size_t OFF_W = OFF_B + SZ_B;
constexpr size_t W_IN_AB = 0;
constexpr size_t W_OUT_AB = W_IN_AB + 2ull * 3145728;
constexpr size_t W_GLU = W_OUT_AB + 2ull * 1048576;
constexpr size_t W_IN_C = W_GLU + 2ull * 262144;
constexpr size_t W_OUT_C = W_IN_C + 2ull * 4194304;
constexpr size_t W_TOTAL = W_OUT_C + 2ull * 1048576;
constexpr size_t OFF_MOD = OFF_W + W_TOTAL * 2;
constexpr size_t OFF_COS = OFF_MOD + 4ull * 12 * 3072 * 4;
constexpr size_t OFF_SIN = OFF_COS + 8192ull * 64 * 4;
constexpr size_t WS_END = OFF_SIN + 8192ull * 64 * 4;
constexpr size_t OFF_BAR = WS_END;
constexpr int ZE_LD = 2048;
constexpr size_t ZE_US = (size_t)T_TOK * ZE_LD * 2;
constexpr size_t ZE_VT = ZE_US + 100663296ull;
constexpr size_t ZE_KT = ZE_VT + 100663296ull;
constexpr size_t ZE_E = ZE_KT + 100663296ull;
constexpr size_t ZE_CARRY = ZE_E + 50331648ull;
constexpr int ZO_LD = 3072;
constexpr size_t ZO_VT = (size_t)T_TOK * ZO_LD * 2;
constexpr size_t B_YG = 0;
constexpr size_t B_KMAT = 100663296ull;
constexpr size_t B_EMAT = B_KMAT + 83886080ull;

struct Params {
    const float *x_prompt, *x_sample, *c_prompt, *c_sample, *norm_pre, *norm_post, *w_mod, *b_mod;
    const float *w_in_ab, *w_out_ab, *a_re, *a_im, *log_step, *b_re, *b_im, *c_re, *c_im, *ssm_d, *w_glu;
    const float *w_in_c, *w_out_c, *rel_bias;
    float* out;
    unsigned char* ws;
    int hb;
    int pad_;
};

__device__ __forceinline__ float bf2f(unsigned short u) { return __uint_as_float(((unsigned)u) << 16); }
__device__ __forceinline__ unsigned pk2(float lo, float hi) {
    unsigned r;
    asm("v_cvt_pk_bf16_f32 %0, %1, %2" : "=v"(r) : "v"(lo), "v"(hi));
    return r;
}
__device__ __forceinline__ bf16_t f2bf(float v) { return (bf16_t)(pk2(v, 0.f) & 0xffffu); }
__device__ __forceinline__ float sigmoidf_(float x) { return 1.f / (1.f + __expf(-x)); }
__device__ __forceinline__ float siluf_(float x) { return x / (1.f + __expf(-x)); }
__device__ __forceinline__ float gelu_tanh(float y) {
    const float u = 0.7978845608028654f * (y + 0.044715f * y * y * y);
    const float e = __expf(2.f * u);
    const float th = 1.f - 2.f / (e + 1.f);
    return 0.5f * y * (1.f + th);
}
__device__ __forceinline__ void st4(bf16_t* dst, float a, float b, float c, float d) {
    uint2 v; v.x = pk2(a, b); v.y = pk2(c, d);
    *(uint2*)dst = v;
}
__device__ __forceinline__ void ld4(const bf16_t* src, float& a, float& b, float& c, float& d) {
    const uint2 v = *(const uint2*)src;
    a = __uint_as_float(v.x << 16); b = __uint_as_float(v.x & 0xffff0000u);
    c = __uint_as_float(v.y << 16); d = __uint_as_float(v.y & 0xffff0000u);
}
__device__ __forceinline__ uint4 scale8(uint4 v, float s) {
    uint4 o;
    o.x = pk2(__uint_as_float(v.x << 16) * s, __uint_as_float(v.x & 0xffff0000u) * s);
    o.y = pk2(__uint_as_float(v.y << 16) * s, __uint_as_float(v.y & 0xffff0000u) * s);
    o.z = pk2(__uint_as_float(v.z << 16) * s, __uint_as_float(v.z & 0xffff0000u) * s);
    o.w = pk2(__uint_as_float(v.w << 16) * s, __uint_as_float(v.w & 0xffff0000u) * s);
    return o;
}
__device__ __forceinline__ const float* x_row(const Params& p, int row) {
    return row < 4 * SEQL ? p.x_prompt + (size_t)row * DM : p.x_sample + (size_t)(row - 4 * SEQL) * DM;
}
__device__ __forceinline__ const float* c_row(const Params& p, int b) {
    return b < 4 ? p.c_prompt + (size_t)b * DM : p.c_sample + (size_t)(b - 4) * DM;
}
__device__ __forceinline__ float log2_gamma(int h) { return log2f(1.f - exp2f(-5.f - (float)h)); }

__device__ __forceinline__ int lane_id() { int l; asm volatile("v_mbcnt_lo_u32_b32 %0, -1, 0\n\tv_mbcnt_hi_u32_b32 %0, -1, %0" : "=v"(l)); return l; }
#define tidx() tid_of(wv & 3)
#define t512x() tid_of(wv)
__device__ __forceinline__ int tid_of(int w) { int t = w * 64 + lane_id(); asm volatile("" : "+v"(t)); return t; }
#define VB ((int)blockIdx.x * 2 + hb)
#define VG ((int)gridDim.x * 2)
constexpr int LDS_PITCH = 144;
constexpr int STAGE_B = 128 * LDS_PITCH;
constexpr int LDS_TOTAL = 4 * STAGE_B + 2048;

__device__ __forceinline__ void compute_ktile(f32x16 (&acc)[2][2], const unsigned char* Ab, const unsigned char* Bb, int tid, bool swap) {
    const int lane = tid & 63, wave = tid >> 6, wm = wave >> 1, wn = wave & 1;
    const int l31 = lane & 31, half = lane >> 5;
    const unsigned char* ap = Ab + (wm * 64 + l31) * LDS_PITCH + half * 16;
    const unsigned char* bp = Bb + (wn * 32 + l31) * LDS_PITCH + half * 16;
    if (swap) {
#pragma unroll
        for (int ks = 0; ks < 4; ++ks) {
            bf16x8 a[2], b[2];
            a[0] = *(const bf16x8*)(ap + ks * 32);
            a[1] = *(const bf16x8*)(ap + 32 * LDS_PITCH + ks * 32);
            b[0] = *(const bf16x8*)(bp + ks * 32);
            b[1] = *(const bf16x8*)(bp + 64 * LDS_PITCH + ks * 32);
#pragma unroll
            for (int mi = 0; mi < 2; ++mi)
#pragma unroll
                for (int nj = 0; nj < 2; ++nj) acc[mi][nj] = __builtin_amdgcn_mfma_f32_32x32x16_bf16(b[nj], a[mi], acc[mi][nj], 0, 0, 0);
        }
    } else {
#pragma unroll
        for (int ks = 0; ks < 4; ++ks) {
            bf16x8 a[2], b[2];
            a[0] = *(const bf16x8*)(ap + ks * 32);
            a[1] = *(const bf16x8*)(ap + 32 * LDS_PITCH + ks * 32);
            b[0] = *(const bf16x8*)(bp + ks * 32);
            b[1] = *(const bf16x8*)(bp + 64 * LDS_PITCH + ks * 32);
#pragma unroll
            for (int mi = 0; mi < 2; ++mi)
#pragma unroll
                for (int nj = 0; nj < 2; ++nj) acc[mi][nj] = __builtin_amdgcn_mfma_f32_32x32x16_bf16(a[mi], b[nj], acc[mi][nj], 0, 0, 0);
        }
    }
}

template <class AL, class BL>
__device__ __forceinline__ void gemm_kloop1(f32x16 (&acc)[2][2], const AL& al, const BL& bl, int nk, unsigned char* lds, int tid, bool swap = true) {
    const int srow = tid >> 3, skc = (tid & 7) * 8;
    uint4 ra[4], rb[4];
#pragma unroll
    for (int i = 0; i < 4; ++i) { ra[i] = al(srow + 32 * i, skc); rb[i] = bl(srow + 32 * i, skc); }
    __syncthreads();
#pragma unroll
    for (int i = 0; i < 4; ++i) {
        *(uint4*)(lds + (srow + 32 * i) * LDS_PITCH + skc * 2) = ra[i];
        *(uint4*)(lds + 2 * STAGE_B + (srow + 32 * i) * LDS_PITCH + skc * 2) = rb[i];
    }
    __syncthreads();
#pragma unroll 1
    for (int kt = 0; kt < nk; ++kt) {
        const int cur = kt & 1;
        const bool more = (kt + 1 < nk);
        if (more) {
            const int k = (kt + 1) * 64 + skc;
#pragma unroll
            for (int i = 0; i < 4; ++i) { ra[i] = al(srow + 32 * i, k); rb[i] = bl(srow + 32 * i, k); }
        }
        compute_ktile(acc, lds + cur * STAGE_B, lds + 2 * STAGE_B + cur * STAGE_B, tid, swap);
        if (more) {
            const int nxt = cur ^ 1;
#pragma unroll
            for (int i = 0; i < 4; ++i) {
                *(uint4*)(lds + nxt * STAGE_B + (srow + 32 * i) * LDS_PITCH + skc * 2) = ra[i];
                *(uint4*)(lds + 2 * STAGE_B + nxt * STAGE_B + (srow + 32 * i) * LDS_PITCH + skc * 2) = rb[i];
            }
        }
        __syncthreads();
    }
}

template <class AL, class BL>
__device__ __forceinline__ void gemm_kloop(f32x16 (&acc)[2][2], const AL& al, const BL& bl, int nk, unsigned char* lds, int tid, bool swap = true) {
    const int srow = tid >> 3, skc = (tid & 7) * 8;
    uint4 ra0[4], rb0[4], ra1[4], rb1[4];
#define GK_LOAD(RA, RB, KT) { const int k_ = (KT) * 64 + skc; _Pragma("unroll") for (int i = 0; i < 4; ++i) { RA[i] = al(srow + 32 * i, k_); RB[i] = bl(srow + 32 * i, k_); } }
#define GK_STORE(RA, RB, BUF) { _Pragma("unroll") for (int i = 0; i < 4; ++i) { \
        *(uint4*)(lds + (BUF) * STAGE_B + (srow + 32 * i) * LDS_PITCH + skc * 2) = RA[i]; \
        *(uint4*)(lds + 2 * STAGE_B + (BUF) * STAGE_B + (srow + 32 * i) * LDS_PITCH + skc * 2) = RB[i]; } }
    const int last = nk - 1;
    GK_LOAD(ra0, rb0, 0);
    GK_LOAD(ra1, rb1, 1);
    __syncthreads();
    GK_STORE(ra0, rb0, 0);
    GK_LOAD(ra0, rb0, (2 < last ? 2 : last));
    __syncthreads();
#pragma unroll 1
    for (int kt = 0; kt < nk; kt += 2) {
        compute_ktile(acc, lds, lds + 2 * STAGE_B, tid, swap);
        GK_STORE(ra1, rb1, 1);
        __builtin_amdgcn_sched_barrier(0);
        GK_LOAD(ra1, rb1, (kt + 3 < last ? kt + 3 : last));
        __syncthreads();
        compute_ktile(acc, lds + STAGE_B, lds + 3 * STAGE_B, tid, swap);
        GK_STORE(ra0, rb0, 0);
        __builtin_amdgcn_sched_barrier(0);
        GK_LOAD(ra0, rb0, (kt + 4 < last ? kt + 4 : last));
        __syncthreads();
    }
#undef GK_LOAD
#undef GK_STORE
}

constexpr int ST2_B = 65536;
__device__ __forceinline__ void compute_ktile256(f32x16 (&acc)[2][4], const unsigned char* Ab, const unsigned char* Bb, int t512) {
    const int lane = t512 & 63, wave = t512 >> 6, wm = wave >> 1, wn = wave & 1;
    const int l31 = lane & 31, half = lane >> 5;
    const int swz = (l31 >> 1) & 7;
    const unsigned char* ap = Ab + (wm * 64 + l31) * 128;
    const unsigned char* bp = Bb + (wn * 128 + l31) * 128;
#pragma unroll
    for (int ks = 0; ks < 4; ++ks) {
        const int off = ((ks * 2 + half) ^ swz) * 16;
        bf16x8 a[2], b[4];
        a[0] = *(const bf16x8*)(ap + off);
        a[1] = *(const bf16x8*)(ap + 32 * 128 + off);
#pragma unroll
        for (int nj = 0; nj < 4; ++nj) b[nj] = *(const bf16x8*)(bp + nj * 32 * 128 + off);
#pragma unroll
        for (int mi = 0; mi < 2; ++mi)
#pragma unroll
            for (int nj = 0; nj < 4; ++nj) acc[mi][nj] = __builtin_amdgcn_mfma_f32_32x32x16_bf16(a[mi], b[nj], acc[mi][nj], 0, 0, 0);
    }
}

template <class AL, class BL>
__device__ __forceinline__ void gemm256_kloop(f32x16 (&acc)[2][4], const AL& al, const BL& bl, int nk, unsigned char* lds0, int t512) {
    const int srow = t512 >> 3;
    const int csrc = ((t512 & 7) ^ ((srow >> 1) & 7)) * 8;
#define G2_ISSUE(BUF, KT) { const int k_ = (KT) * 64 + csrc; _Pragma("unroll") for (int i = 0; i < 4; ++i) { \
        __builtin_amdgcn_global_load_lds((const unsigned*)al(srow + 64 * i, k_), (unsigned*)(lds0 + (BUF) * ST2_B + i * 8192 + t512 * 16), 16, 0, 0); \
        __builtin_amdgcn_global_load_lds((const unsigned*)bl(srow + 64 * i, k_), (unsigned*)(lds0 + (BUF) * ST2_B + 32768 + i * 8192 + t512 * 16), 16, 0, 0); } }
    const int last = nk - 1;
    __syncthreads();
    G2_ISSUE(0, 0);
    __syncthreads();
#pragma unroll 1
    for (int kt = 0; kt < nk; kt += 2) {
        G2_ISSUE(1, (kt + 1));
        compute_ktile256(acc, lds0, lds0 + 32768, t512);
        __syncthreads();
        G2_ISSUE(0, (kt + 2 < last ? kt + 2 : last));
        compute_ktile256(acc, lds0 + ST2_B, lds0 + ST2_B + 32768, t512);
        __syncthreads();
    }
#undef G2_ISSUE
}

#define ROWU(mi, reg) (wm * 64 + (mi) * 32 + 8 * ((reg) >> 2) + ((reg) & 3))
__device__ __forceinline__ void zero_acc256(f32x16 (&acc)[2][4]) {
#pragma unroll
    for (int i = 0; i < 2; ++i)
#pragma unroll
        for (int j = 0; j < 4; ++j)
#pragma unroll
            for (int e = 0; e < 16; ++e) acc[i][j][e] = 0.f;
}
__device__ __forceinline__ bool tile256(int it, int NT, int ntiles, int& mt, int& nt) {
    const int G = gridDim.x, b = blockIdx.x;
    if ((G & 7) == 0) {
        const int s = it * (G >> 3) + (b >> 3);
        if (s >= (ntiles >> 3)) return false;
        mt = (s / NT) * 8 + (b & 7); nt = s % NT;
    } else {
        const int t = it * G + b;
        if (t >= ntiles) return false;
        mt = t / NT; nt = t % NT;
    }
    return true;
}
__device__ __forceinline__ bool tile256_in(int it, int NT, int& mt, int& nt) {
    const int G = gridDim.x, b = blockIdx.x;
    if ((G & 7) == 0) {
        const int NG = NT >> 2;
        const int s = it * (G >> 3) + (b >> 3);
        const int ml = s / NG;
        if (ml >= 192) return false;
        const int x = b & 7;
        mt = (x >> 2) * 192 + ml; nt = (x & 3) * NG + (s - ml * NG);
    } else {
        const int t = it * G + b;
        if (t >= 384 * NT) return false;
        mt = t / NT; nt = t % NT;
    }
    return true;
}

__device__ __forceinline__ void zero_acc(f32x16 (&acc)[2][2]) {
#pragma unroll
    for (int i = 0; i < 2; ++i)
#pragma unroll
        for (int j = 0; j < 2; ++j)
#pragma unroll
            for (int e = 0; e < 16; ++e) acc[i][j][e] = 0.f;
}

__device__ __forceinline__ void transpose_tile(const float* src, int K, int N, bf16_t* dst, int tile, unsigned char* lds, int wv) {
    float* tl = (float*)lds;
    const int ntn = N / 64;
    const int k0 = (tile / ntn) * 64, n0 = (tile % ntn) * 64;
    const int tid = tidx();
    __syncthreads();
#pragma unroll
    for (int i = 0; i < 4; ++i) {
        const int r = (tid >> 4) + 16 * i, c4 = (tid & 15) * 4;
        const float4 v = *(const float4*)(src + (size_t)(k0 + r) * N + n0 + c4);
        tl[r * 65 + c4 + 0] = v.x; tl[r * 65 + c4 + 1] = v.y; tl[r * 65 + c4 + 2] = v.z; tl[r * 65 + c4 + 3] = v.w;
    }
    __syncthreads();
#pragma unroll
    for (int i = 0; i < 2; ++i) {
        const int n = (tid >> 3) + 32 * i, k8 = (tid & 7) * 8;
        uint4 o;
        o.x = pk2(tl[(k8 + 0) * 65 + n], tl[(k8 + 1) * 65 + n]);
        o.y = pk2(tl[(k8 + 2) * 65 + n], tl[(k8 + 3) * 65 + n]);
        o.z = pk2(tl[(k8 + 4) * 65 + n], tl[(k8 + 5) * 65 + n]);
        o.w = pk2(tl[(k8 + 6) * 65 + n], tl[(k8 + 7) * 65 + n]);
        *(uint4*)(dst + (size_t)(n0 + n) * K + k0 + k8) = o;
    }
}

__device__ __forceinline__ void mod_tile(const Params& p, int tile, unsigned char* lds, int wv) {
    float* sc = (float*)lds;
    float* red = (float*)(lds + 49152);
    const int L = tile / 96, n0 = (tile % 96) * 32;
    const int tid = tidx();
    __syncthreads();
    for (int i = tid; i < 12 * 1024; i += 256) {
        const int b = i >> 10, k = i & 1023;
        sc[i] = siluf_(c_row(p, b)[k]);
    }
    __syncthreads();
    const int kg = tid >> 5, col = tid & 31;
    float a[12];
#pragma unroll
    for (int b = 0; b < 12; ++b) a[b] = 0.f;
    const float* w = p.w_mod + (size_t)L * 1024 * 3072 + n0 + col;
#pragma unroll 1
    for (int k0 = kg * 128; k0 < kg * 128 + 128; k0 += 8) {
        float wq[8];
#pragma unroll
        for (int u = 0; u < 8; ++u) wq[u] = w[(size_t)(k0 + u) * 3072];
#pragma unroll
        for (int u = 0; u < 8; ++u)
#pragma unroll
            for (int b = 0; b < 12; ++b) a[b] += sc[b * 1024 + k0 + u] * wq[u];
    }
#pragma unroll
    for (int b = 0; b < 12; ++b) red[(kg * 12 + b) * 32 + col] = a[b];
    __syncthreads();
    for (int i = tid; i < 12 * 32; i += 256) {
        const int b = i >> 5, c = i & 31;
        float s = 0.f;
#pragma unroll
        for (int g = 0; g < 8; ++g) s += red[(g * 12 + b) * 32 + c];
        float* mod = (float*)(p.ws + OFF_MOD);
        mod[((size_t)L * 12 + b) * 3072 + n0 + c] = s + p.b_mod[(size_t)L * 3072 + n0 + c];
    }
}

__device__ __forceinline__ void phase_prologue(const Params& p, unsigned char* lds, int hb, int wv) {
    bf16_t* W = (bf16_t*)(p.ws + OFF_W);
    const int NTR = 4736, NMOD = 384, NROT = 2048;
    for (int t = VB; t < NTR + NMOD + NROT; t += VG) {
        if (t < NTR) {
            const float* src; int K, N; bf16_t* dst; int tile;
            if (t < 1536)      { const int j = t / 768;          tile = t % 768;          src = p.w_in_ab + (size_t)j * 3145728; K = 1024; N = 3072; dst = W + W_IN_AB + (size_t)j * 3145728; }
            else if (t < 2048) { const int j = (t - 1536) / 256; tile = (t - 1536) % 256; src = p.w_out_ab + (size_t)j * 1048576; K = 1024; N = 1024; dst = W + W_OUT_AB + (size_t)j * 1048576; }
            else if (t < 2176) { const int j = (t - 2048) / 64;  tile = (t - 2048) % 64;  src = p.w_glu + (size_t)j * 262144; K = 512; N = 512; dst = W + W_GLU + (size_t)j * 262144; }
            else if (t < 4224) { const int j = (t - 2176) / 1024; tile = (t - 2176) % 1024; src = p.w_in_c + (size_t)j * 4194304; K = 1024; N = 4096; dst = W + W_IN_C + (size_t)j * 4194304; }
            else               { const int j = (t - 4224) / 256; tile = (t - 4224) % 256; src = p.w_out_c + (size_t)j * 1048576; K = 1024; N = 1024; dst = W + W_OUT_C + (size_t)j * 1048576; }
            transpose_tile(src, K, N, dst, tile, lds, wv);
        } else if (t < NTR + NMOD) {
            mod_tile(p, t - NTR, lds, wv);
        } else {
            const int idx = (t - NTR - NMOD) * 256 + tidx();
            const int pos = idx >> 6, i = idx & 63;
            const float inv = powf(10000.f, -(float)(2 * i) / 128.f);
            const float ang = (float)pos * inv;
            float s, c;
            sincosf(ang, &s, &c);
            ((float*)(p.ws + OFF_COS))[idx] = c;
            ((float*)(p.ws + OFF_SIN))[idx] = s;
        }
    }
}

__device__ __forceinline__ void phase_norm(const Params& p, int L, int hb, int wv) {
    const int tid = tidx();
    const int lane = tid & 63, wave = tid >> 6;
    bf16_t* B = (bf16_t*)(p.ws + OFF_B);
    const float* mod = (const float*)(p.ws + OFF_MOD);
#define XBF(r) ((bf16_t*)((unsigned char*)p.out + (size_t)(r) * 4096 + 2048))
    float4 xn[4];
    uint2 xbn[4] = {make_uint2(0u, 0u), make_uint2(0u, 0u), make_uint2(0u, 0u), make_uint2(0u, 0u)};
    uint2 yn[4];
    {
        const int row = VB * 4 + wave;
#pragma unroll
        for (int i = 0; i < 4; ++i) {
            if (L <= 1) xn[i] = *(const float4*)(x_row(p, row) + i * 256 + lane * 4);
            else { xbn[i] = *(const uint2*)(XBF(row) + i * 256 + lane * 4); xn[i] = make_float4(0.f, 0.f, 0.f, 0.f); }
            yn[i] = (L >= 1) ? *(const uint2*)(B + (size_t)row * DM + i * 256 + lane * 4) : make_uint2(0u, 0u);
        }
    }
    float4 g4a[4], n4a[4], sha[4], scla[4], npa[4];
#pragma unroll
    for (int i = 0; i < 4; ++i) {
        g4a[i] = n4a[i] = sha[i] = scla[i] = npa[i] = make_float4(0.f, 0.f, 0.f, 0.f);
        if (L >= 1) n4a[i] = *(const float4*)(p.norm_post + (size_t)(L - 1) * DM + i * 256 + lane * 4);
        if (L <= 3) npa[i] = *(const float4*)(p.norm_pre + (size_t)L * DM + i * 256 + lane * 4);
    }
    int bprev = -1;
    for (int t = VB; t < T_TOK / 4; t += VG) {
        const int row = t * 4 + wave;
        const int b = row / SEQL;
        if (b != bprev) {
            bprev = b;
#pragma unroll
            for (int i = 0; i < 4; ++i) {
                if (L >= 1) g4a[i] = *(const float4*)(mod + ((size_t)(L - 1) * 12 + b) * 3072 + 2048 + i * 256 + lane * 4);
                if (L <= 3) {
                    sha[i] = *(const float4*)(mod + ((size_t)L * 12 + b) * 3072 + i * 256 + lane * 4);
                    scla[i] = *(const float4*)(mod + ((size_t)L * 12 + b) * 3072 + 1024 + i * 256 + lane * 4);
                }
            }
        }
        float x[16], y[16];
#pragma unroll
        for (int i = 0; i < 4; ++i) {
            if (L <= 1) { x[4 * i] = xn[i].x; x[4 * i + 1] = xn[i].y; x[4 * i + 2] = xn[i].z; x[4 * i + 3] = xn[i].w; }
            else {
                x[4 * i] = __uint_as_float(xbn[i].x << 16); x[4 * i + 1] = __uint_as_float(xbn[i].x & 0xffff0000u);
                x[4 * i + 2] = __uint_as_float(xbn[i].y << 16); x[4 * i + 3] = __uint_as_float(xbn[i].y & 0xffff0000u);
            }
            y[4 * i] = __uint_as_float(yn[i].x << 16); y[4 * i + 1] = __uint_as_float(yn[i].x & 0xffff0000u);
            y[4 * i + 2] = __uint_as_float(yn[i].y << 16); y[4 * i + 3] = __uint_as_float(yn[i].y & 0xffff0000u);
        }
        {
            const int tn = (t + VG < T_TOK / 4) ? t + VG : t;
            const int rown = tn * 4 + wave;
#pragma unroll
            for (int i = 0; i < 4; ++i) {
                if (L <= 1) xn[i] = *(const float4*)(x_row(p, rown) + i * 256 + lane * 4);
                else xbn[i] = *(const uint2*)(XBF(rown) + i * 256 + lane * 4);
                if (L >= 1) yn[i] = *(const uint2*)(B + (size_t)rown * DM + i * 256 + lane * 4);
            }
        }
        if (L >= 1) {
            float ss = 0.f;
#pragma unroll
            for (int e = 0; e < 16; ++e) ss += y[e] * y[e];
#pragma unroll
            for (int o = 32; o >= 1; o >>= 1) ss += __shfl_xor(ss, o);
            const float ry = rsqrtf(ss * (1.f / 1024.f) + EPSF);
#pragma unroll
            for (int i = 0; i < 4; ++i) {
                const int c = i * 256 + lane * 4;
                const float4 g4 = g4a[i];
                const float4 n4 = n4a[i];
                x[4 * i + 0] += g4.x * (y[4 * i + 0] * ry * n4.x);
                x[4 * i + 1] += g4.y * (y[4 * i + 1] * ry * n4.y);
                x[4 * i + 2] += g4.z * (y[4 * i + 2] * ry * n4.z);
                x[4 * i + 3] += g4.w * (y[4 * i + 3] * ry * n4.w);
                if (L == 4) {
                    float4 o; o.x = x[4 * i]; o.y = x[4 * i + 1]; o.z = x[4 * i + 2]; o.w = x[4 * i + 3];
                    *(float4*)(p.out + (size_t)row * DM + c) = o;
                } else {
                    st4(XBF(row) + c, x[4 * i], x[4 * i + 1], x[4 * i + 2], x[4 * i + 3]);
                }
            }
        }
        if (L <= 3) {
            float ss = 0.f;
#pragma unroll
            for (int e = 0; e < 16; ++e) ss += x[e] * x[e];
#pragma unroll
            for (int o = 32; o >= 1; o >>= 1) ss += __shfl_xor(ss, o);
            const float rx = rsqrtf(ss * (1.f / 1024.f) + EPSF);
#pragma unroll
            for (int i = 0; i < 4; ++i) {
                const int c = i * 256 + lane * 4;
                const float4 sh = sha[i];
                const float4 scl = scla[i];
                const float4 n4 = npa[i];
                const float h0 = x[4 * i + 0] * rx * n4.x * (1.f + scl.x) + sh.x;
                const float h1 = x[4 * i + 1] * rx * n4.y * (1.f + scl.y) + sh.y;
                const float h2 = x[4 * i + 2] * rx * n4.z * (1.f + scl.z) + sh.z;
                const float h3 = x[4 * i + 3] * rx * n4.w * (1.f + scl.w) + sh.w;
                st4(B + (size_t)row * DM + c, h0, h1, h2, h3);
            }
        }
    }
}

__device__ __forceinline__ void phase_inproj_even(const Params& p, int j, unsigned char* lds0, int hb, int wv) {
    const bf16_t* H = (const bf16_t*)(p.ws + OFF_B);
    const bf16_t* Wt = (const bf16_t*)(p.ws + OFF_W) + W_IN_AB + (size_t)j * 3145728;
    bf16_t* Z = (bf16_t*)(p.ws + OFF_Z);
    bf16_t* VT = (bf16_t*)(p.ws + OFF_Z + ZE_VT);
    bf16_t* KT = (bf16_t*)(p.ws + OFF_Z + ZE_KT);
    const float* COS = (const float*)(p.ws + OFF_COS);
    const float* SIN = (const float*)(p.ws + OFF_SIN);
    const int t512 = t512x();
    for (int it = 0;; ++it) {
        int mt, nt;
        if (!tile256_in(it, 12, mt, nt)) break;
        const int m0 = mt * 256, n0 = nt * 256;
        const bf16_t* Hm = H + (size_t)m0 * 1024;
        const bf16_t* Wn = Wt + (size_t)n0 * 1024;
        auto al = [&](int r, int k) { return Hm + (unsigned)(r * 1024 + k); };
        auto bl = [&](int r, int k) { return Wn + (unsigned)(r * 1024 + k); };
        f32x16 acc[2][4];
        zero_acc256(acc);
        gemm256_kloop(acc, al, bl, 16, lds0, t512);
        int tq = t512;
        asm volatile("" : "+v"(tq));
        const int lane = tq & 63, wave = tq >> 6, wm = wave >> 1, wn = wave & 1, l31 = lane & 31, half = lane >> 5;
        const int cw = n0 + wn * 128;
        const int seg = cw >> 9;
        const int bb = m0 / SEQL;
        const int rbase = m0 + wm * 64 + 4 * half;
        if (seg == 2) {
#pragma unroll
            for (int mi = 0; mi < 2; ++mi)
#pragma unroll
                for (int nj = 0; nj < 4; ++nj) {
                    const int n = cw - 1024 + nj * 32 + l31;
#pragma unroll
                    for (int q4 = 0; q4 < 4; ++q4) {
                        const int pos = (rbase % SEQL) + mi * 32 + 8 * q4;
                        st4(VT + ((size_t)bb * 512 + n) * SEQL + pos, acc[mi][nj][4 * q4], acc[mi][nj][4 * q4 + 1], acc[mi][nj][4 * q4 + 2], acc[mi][nj][4 * q4 + 3]);
                    }
                }
        } else if (seg <= 1) {
            const float ksc = (seg == 1) ? 0.08838834764831845f : 1.f;
            const int hd = (cw & 511) >> 7;
#pragma unroll
            for (int mi = 0; mi < 2; ++mi)
#pragma unroll
                for (int nj = 0; nj < 2; ++nj) {
                    const int d = nj * 32 + l31;
#pragma unroll
                    for (int hq = 0; hq < 2; ++hq) {
                        float cc8[8], sn8[8];
#pragma unroll
                        for (int r8 = 0; r8 < 8; ++r8) {
                            const int pos = (rbase + mi * 32 + 8 * (hq * 2 + (r8 >> 2)) + (r8 & 3)) % SEQL;
                            cc8[r8] = COS[pos * 64 + d]; sn8[r8] = SIN[pos * 64 + d];
                        }
#pragma unroll
                        for (int qq = 0; qq < 2; ++qq) {
                            const int q4 = hq * 2 + qq;
                            float o1[4], o2[4];
                            const int row0 = rbase + mi * 32 + 8 * q4;
#pragma unroll
                            for (int r = 0; r < 4; ++r) {
                                const int row = row0 + r;
                                const float cc = cc8[qq * 4 + r], sn = sn8[qq * 4 + r];
                                const float x1 = acc[mi][nj][4 * q4 + r], x2 = acc[mi][nj + 2][4 * q4 + r];
                                o1[r] = (x1 * cc - x2 * sn) * ksc;
                                o2[r] = (x1 * sn + x2 * cc) * ksc;
                                Z[(size_t)row * ZE_LD + cw + d] = f2bf(o1[r]);
                                Z[(size_t)row * ZE_LD + cw + 64 + d] = f2bf(o2[r]);
                            }
                            if (seg == 1) {
                                bf16_t* kt = KT + ((size_t)(bb * 4 + hd) * 128) * SEQL + (row0 % SEQL);
                                st4(kt + (size_t)d * SEQL, o1[0], o1[1], o1[2], o1[3]);
                                st4(kt + (size_t)(64 + d) * SEQL, o2[0], o2[1], o2[2], o2[3]);
                            }
                        }
                    }
                }
        } else if (seg == 4) {
            bf16_t* US = (bf16_t*)(p.ws + OFF_Z + ZE_US);
#pragma unroll
            for (int mi = 0; mi < 2; ++mi)
#pragma unroll
                for (int nj = 0; nj < 4; ++nj) {
                    const int n = cw - 2048 + nj * 32 + l31;
                    const int g = n >> 4, i = n & 15;
#pragma unroll
                    for (int reg = 0; reg < 16; ++reg) {
                        const int row = rbase + mi * 32 + 8 * (reg >> 2) + (reg & 3);
                        US[(((size_t)(row >> 6) * 32 + g) * 64 + (row & 63)) * 16 + i] = f2bf(acc[mi][nj][reg]);
                    }
                }
        } else {
            const int cb = (seg == 3) ? cw - 512 : cw - 1024;
#pragma unroll
            for (int mi = 0; mi < 2; ++mi)
#pragma unroll
                for (int nj = 0; nj < 4; ++nj) {
                    const int col = cb + nj * 32 + l31;
#pragma unroll
                    for (int reg = 0; reg < 16; ++reg) {
                        const int row = rbase + mi * 32 + 8 * (reg >> 2) + (reg & 3);
                        Z[(size_t)row * ZE_LD + col] = f2bf(acc[mi][nj][reg]);
                    }
                }
        }
    }
}

__device__ __forceinline__ void phase_inproj_odd(const Params& p, int j, unsigned char* lds0, int hb, int wv) {
    const bf16_t* H = (const bf16_t*)(p.ws + OFF_B);
    const bf16_t* Wt = (const bf16_t*)(p.ws + OFF_W) + W_IN_C + (size_t)j * 4194304;
    bf16_t* Z = (bf16_t*)(p.ws + OFF_Z);
    bf16_t* VT = (bf16_t*)(p.ws + OFF_Z + ZO_VT);
    const int t512 = t512x();
    for (int it = 0;; ++it) {
        int mt, nt;
        if (!tile256_in(it, 16, mt, nt)) break;
        const int m0 = mt * 256, n0 = nt * 256;
        const bf16_t* Hm = H + (size_t)m0 * 1024;
        const bf16_t* Wn = Wt + (size_t)n0 * 1024;
        auto al = [&](int r, int k) { return Hm + (unsigned)(r * 1024 + k); };
        auto bl = [&](int r, int k) { return Wn + (unsigned)(r * 1024 + k); };
        f32x16 acc[2][4];
        zero_acc256(acc);
        gemm256_kloop(acc, al, bl, 16, lds0, t512);
        int tq = t512;
        asm volatile("" : "+v"(tq));
        const int lane = tq & 63, wm = wv >> 1, wn = wv & 1, l31 = lane & 31, half = lane >> 5;
        const int cw = n0 + wn * 128;
        const int seg = cw >> 10;
        if (seg == 2) {
            const int bb = m0 / SEQL, p0 = m0 % SEQL;
            const unsigned lo = (unsigned)(l31 * SEQL + 4 * half);
#pragma unroll
            for (int mi = 0; mi < 2; ++mi)
#pragma unroll
                for (int nj = 0; nj < 4; ++nj) {
                    bf16_t* vb = VT + ((size_t)bb * 1024 + (cw - 2048 + nj * 32)) * SEQL + p0 + wm * 64 + mi * 32;
#pragma unroll
                    for (int q4 = 0; q4 < 4; ++q4)
                        st4(vb + 8 * q4 + lo, acc[mi][nj][4 * q4], acc[mi][nj][4 * q4 + 1], acc[mi][nj][4 * q4 + 2], acc[mi][nj][4 * q4 + 3]);
                }
        } else {
            const float sc = (seg == 0) ? 0.125f : 1.f;
            const int cbase = (seg == 3) ? cw - 1024 : cw;
            const unsigned lo = (unsigned)(4 * half * ZO_LD + l31);
#pragma unroll
            for (int mi = 0; mi < 2; ++mi)
#pragma unroll
                for (int nj = 0; nj < 4; ++nj)
#pragma unroll
                    for (int reg = 0; reg < 16; ++reg) {
                        bf16_t* zb = Z + (size_t)(m0 + ROWU(mi, reg)) * ZO_LD + cbase + nj * 32;
                        zb[lo] = f2bf(acc[mi][nj][reg] * sc);
                    }
        }
    }
}

__device__ __forceinline__ void phase_outproj(const Params& p, int L, unsigned char* lds0, int hb, int wv) {
    const int j = L >> 1;
    const bool even = (L & 1) == 0;
    const bf16_t* Z = (const bf16_t*)(p.ws + OFF_Z);
    const bf16_t* Wt = (const bf16_t*)(p.ws + OFF_W) + (even ? W_OUT_AB : W_OUT_C) + (size_t)j * 1048576;
    bf16_t* Y = (bf16_t*)(p.ws + OFF_B);
    const bf16_t* OBp = (const bf16_t*)(p.ws + OFF_Z + ZE_US);
    const int ld = even ? ZE_LD : ZO_LD;
    const int t512 = t512x();
    for (int it = 0;; ++it) {
        int mt, nt;
        if (!tile256(it, 4, 384 * 4, mt, nt)) break;
        const int m0 = mt * 256, n0 = nt * 256;
        const bf16_t* OBm = OBp + (size_t)m0 * 512;
        const bf16_t* Zm = Z + (size_t)m0 * ld;
        const bf16_t* Wn = Wt + (size_t)n0 * 1024;
        auto al = [&](int r, int k) {
            if (even && k >= 512) return OBm + (unsigned)(r * 512 + (k - 512));
            return Zm + (unsigned)(r * ld + k);
        };
        auto bl = [&](int r, int k) { return Wn + (unsigned)(r * 1024 + k); };
        f32x16 acc[2][4];
        zero_acc256(acc);
        gemm256_kloop(acc, al, bl, 16, lds0, t512);
        int tq = t512;
        asm volatile("" : "+v"(tq));
        const int lane = tq & 63, wm = wv >> 1, wn = wv & 1, l31 = lane & 31, half = lane >> 5;
        {
            const unsigned lo = (unsigned)(4 * half * 1024 + l31);
#pragma unroll
            for (int mi = 0; mi < 2; ++mi)
#pragma unroll
                for (int nj = 0; nj < 4; ++nj)
#pragma unroll
                    for (int reg = 0; reg < 16; ++reg) {
                        bf16_t* yb = Y + (size_t)(m0 + ROWU(mi, reg)) * 1024 + n0 + wn * 128 + nj * 32;
                        yb[lo] = f2bf(acc[mi][nj][reg]);
                    }
        }
    }
}

__device__ __forceinline__ void cpow(float zre, float zim, float k, float& pr, float& pi) {
    const float mag = expf(k * zre);
    float s, c;
    sincosf(k * zim, &s, &c);
    pr = mag * c; pi = mag * s;
}

__device__ __forceinline__ void phase_s5consts(const Params& p, int j, unsigned char* lds, int hb, int wv) {
    bf16_t* KMAT = (bf16_t*)(p.ws + OFF_B + B_KMAT);
    bf16_t* EMAT = (bf16_t*)(p.ws + OFF_B + B_EMAT);
    float* sz = (float*)lds;
    float* sg = (float*)(lds + 4096);
    const int tid = tidx();
    const int NA_ = 32 * 8, NB_ = 32 * 8, NC_ = 32 * 8;
    for (int t = VB; t < NA_ + NB_ + NC_; t += VG) {
        int g, sub, type;
        if (t < NA_) { type = 0; g = t >> 3; sub = t & 7; }
        else if (t < NA_ + NB_) { type = 1; g = (t - NA_) >> 3; sub = (t - NA_) & 7; }
        else { type = 2; g = (t - NA_ - NB_) >> 3; sub = (t - NA_ - NB_) & 7; }
        __syncthreads();
        if (tid < 128) {
            const int dir = tid >> 6, pp = tid & 63;
            const size_t base = ((size_t)(j * 2 + dir) * 32 + g);
            const float delta = expf(p.log_step[base]);
            const float are = p.a_re[base * 64 + pp], aim = p.a_im[base * 64 + pp];
            const float zre = are * delta, zim = aim * delta;
            float abr, abi;
            cpow(zre, zim, 1.f, abr, abi);
            const float den = are * are + aim * aim;
            const float nre = abr - 1.f, nim = abi;
            sz[tid * 4 + 0] = zre; sz[tid * 4 + 1] = zim;
            sz[tid * 4 + 2] = (nre * are + nim * aim) / den;
            sz[tid * 4 + 3] = (nim * are - nre * aim) / den;
        }
        __syncthreads();
        if (type == 0) {
            const int tau0 = sub * 8;
            bf16_t* Kt = (bf16_t*)(lds + 16384);
            const int o = tid >> 4, i = tid & 15;
#pragma unroll 1
            for (int dir = 0; dir < 2; ++dir) {
                const int kmax = dir == 0 ? tau0 + 7 : 63 - tau0;
                const size_t base = ((size_t)(j * 2 + dir) * 32 + g);
                float* scb = (float*)(lds + 53248);
                __syncthreads();
                for (int e = tid; e < 1024; e += 256) {
                    scb[e] = p.c_re[base * 1024 + e];
                    scb[1024 + e] = p.c_im[base * 1024 + e];
                    scb[2048 + e] = p.b_re[base * 1024 + e];
                    scb[3072 + e] = p.b_im[base * 1024 + e];
                }
                const float* cre = scb + o * 64;
                const float* cim = scb + 1024 + o * 64;
                const float* bre = scb + 2048 + i;
                const float* bim = scb + 3072 + i;
#pragma unroll 1
                for (int k0 = 0; k0 <= kmax; k0 += 16) {
                    __syncthreads();
                    for (int e = tid; e < 16 * 64; e += 256) {
                        const int dd = e >> 6, pp = e & 63;
                        float pr, pi;
                        cpow(sz[(dir * 64 + pp) * 4], sz[(dir * 64 + pp) * 4 + 1], (float)(k0 + dd), pr, pi);
                        const float fr = sz[(dir * 64 + pp) * 4 + 2], fi = sz[(dir * 64 + pp) * 4 + 3];
                        sg[e * 2] = pr * fr - pi * fi;
                        sg[e * 2 + 1] = pr * fi + pi * fr;
                    }
                    __syncthreads();
                    float acc[16];
#pragma unroll
                    for (int dd = 0; dd < 16; ++dd) acc[dd] = 0.f;
                    for (int pp = 0; pp < 64; ++pp) {
                        const float cr = cre[pp], ci = cim[pp], br = bre[pp * 16], bi = bim[pp * 16];
                        const float wr = cr * br - ci * bi, wi = cr * bi + ci * br;
#pragma unroll
                        for (int dd = 0; dd < 16; ++dd) { const float2 gg = *(const float2*)(sg + (dd * 64 + pp) * 2); acc[dd] += gg.x * wr - gg.y * wi; }
                    }
#pragma unroll
                    for (int dd = 0; dd < 16; ++dd) {
                        const int k = k0 + dd;
                        if (k <= kmax) {
                            const int didx = (dir == 0 ? k : -k) - (tau0 - 63);
                            float v = acc[dd];
                            if (dir == 1 && k == 0) v += bf2f(Kt[didx * 256 + tid]);
                            Kt[didx * 256 + tid] = f2bf(v);
                        }
                    }
                }
            }
            __syncthreads();
            bf16_t* km = KMAT + (size_t)g * 1024 * 1280;
            for (int v = tid; v < 128 * 128; v += 256) {
                const int rowl = v >> 7, vv = v & 127;
                const int tau = tau0 + (rowl >> 4), oo = rowl & 15, s = vv >> 1, ih = vv & 1;
                const int didx = tau - s - (tau0 - 63);
                const uint4 val = *(const uint4*)(Kt + didx * 256 + oo * 16 + ih * 8);
                *(uint4*)(km + (size_t)(tau * 16 + oo) * 1280 + s * 16 + ih * 8) = val;
            }
        } else if (type == 1) {
            const int dir = tid >> 7, ri = (tid >> 6) & 1, pp = tid & 63;
            const size_t base = ((size_t)(j * 2 + dir) * 32 + g);
            bf16_t* km = KMAT + (size_t)g * 1024 * 1280;
            float cra[16], cia[16];
#pragma unroll
            for (int o = 0; o < 16; ++o) { cra[o] = p.c_re[(base * 16 + o) * 64 + pp]; cia[o] = p.c_im[(base * 16 + o) * 64 + pp]; }
#pragma unroll 1
            for (int u = 0; u < 8; ++u) {
                const int tau = sub * 8 + u;
                float pr, pi;
                const float kk = dir == 0 ? (float)(tau + 1) : (float)(64 - tau);
                cpow(sz[(dir * 64 + pp) * 4], sz[(dir * 64 + pp) * 4 + 1], kk, pr, pi);
#pragma unroll
                for (int o = 0; o < 16; ++o) {
                    const float cr = cra[o], ci = cia[o];
                    const float wr = cr * pr - ci * pi, wi = cr * pi + ci * pr;
                    km[(size_t)(tau * 16 + o) * 1280 + 1024 + tid] = f2bf(ri == 0 ? wr : -wi);
                }
            }
        } else {
            const int dir = tid >> 7, ri = (tid >> 6) & 1, pp = tid & 63;
            const float fr = sz[(dir * 64 + pp) * 4 + 2], fi = sz[(dir * 64 + pp) * 4 + 3];
            const size_t base = ((size_t)(j * 2 + dir) * 32 + g);
            const float* bre = p.b_re + (base * 64 + pp) * 16;
            const float* bim = p.b_im + (base * 64 + pp) * 16;
            float bra[16], bia[16];
#pragma unroll
            for (int i = 0; i < 16; ++i) { bra[i] = bre[i]; bia[i] = bim[i]; }
#pragma unroll 1
            for (int u = 0; u < 8; ++u) {
                const int s = sub * 8 + u;
                float pr, pi;
                const float kk = dir == 0 ? (float)(63 - s) : (float)s;
                cpow(sz[(dir * 64 + pp) * 4], sz[(dir * 64 + pp) * 4 + 1], kk, pr, pi);
                const float gr = pr * fr - pi * fi, gi = pr * fi + pi * fr;
                float v[16];
#pragma unroll
                for (int i = 0; i < 16; ++i) {
                    const float br = bra[i], bi = bia[i];
                    v[i] = ri == 0 ? (gr * br - gi * bi) : (gr * bi + gi * br);
                }
                uint4 o0, o1;
                o0.x = pk2(v[0], v[1]); o0.y = pk2(v[2], v[3]); o0.z = pk2(v[4], v[5]); o0.w = pk2(v[6], v[7]);
                o1.x = pk2(v[8], v[9]); o1.y = pk2(v[10], v[11]); o1.z = pk2(v[12], v[13]); o1.w = pk2(v[14], v[15]);
                bf16_t* em = EMAT + ((size_t)g * 256 + tid) * 1024 + s * 16;
                *(uint4*)em = o0;
                *(uint4*)(em + 8) = o1;
            }
        }
    }
}

__device__ __forceinline__ void phase_s5A(const Params& p, unsigned char* lds0, int hb, int wv) {
    const bf16_t* US = (const bf16_t*)(p.ws + OFF_Z + ZE_US);
    const bf16_t* EMAT = (const bf16_t*)(p.ws + OFF_B + B_EMAT);
    float* E = (float*)(p.ws + OFF_Z + ZE_E);
    const int t512 = t512x();
    for (int t = blockIdx.x; t < 32 * 6; t += gridDim.x) {
        const int g = t / 6, mt = t % 6, m0 = mt * 256;
        const bf16_t* USg = US + ((size_t)m0 * 32 + g) * 1024;
        const bf16_t* EMg = EMAT + (size_t)g * 256 * 1024;
        auto al = [&](int r, int k) { return USg + (unsigned)(r * 32768 + k); };
        auto bl = [&](int r, int k) { return EMg + (unsigned)(r * 1024 + k); };
        f32x16 acc[2][4];
        zero_acc256(acc);
        gemm256_kloop(acc, al, bl, 16, lds0, t512);
        int tq = t512;
        asm volatile("" : "+v"(tq));
        const int lane = tq & 63, wm = wv >> 1, wn = wv & 1, l31 = lane & 31, half = lane >> 5;
        const unsigned lo = (unsigned)(4 * half * 8192 + l31);
#pragma unroll
        for (int mi = 0; mi < 2; ++mi)
#pragma unroll
            for (int nj = 0; nj < 4; ++nj)
#pragma unroll
                for (int reg = 0; reg < 16; ++reg) {
                    float* eb = E + ((size_t)(m0 + ROWU(mi, reg)) * 32 + g) * 256 + wn * 128 + nj * 32;
                    eb[lo] = acc[mi][nj][reg];
                }
    }
}

__device__ __forceinline__ void phase_s5scan(const Params& p, int j, int hb, int wv) {
    const float* E = (const float*)(p.ws + OFF_Z + ZE_E);
    bf16_t* CARRY = (bf16_t*)(p.ws + OFF_Z + ZE_CARRY);
    for (int it = VB * 256 + tidx(); it < 12 * 32 * 2 * 64; it += VG * 256) {
        const int pp = it & 63, dir = (it >> 6) & 1, g = (it >> 7) & 31, b = it >> 12;
        const size_t base = ((size_t)(j * 2 + dir) * 32 + g);
        const float delta = expf(p.log_step[base]);
        const float zre = p.a_re[base * 64 + pp] * delta, zim = p.a_im[base * 64 + pp] * delta;
        float ar, ai;
        cpow(zre, zim, 64.f, ar, ai);
        float fr = 0.f, fi = 0.f;
#pragma unroll 1
        for (int s0 = 0; s0 < 128; s0 += 32) {
            float er[32], ei[32];
#pragma unroll
            for (int u = 0; u < 32; ++u) {
                const int n = dir == 0 ? (s0 + u) : 127 - (s0 + u);
                const size_t idx = ((size_t)(b * 128 + n) * 32 + g) * 256 + dir * 128 + pp;
                er[u] = E[idx]; ei[u] = E[idx + 64];
            }
#pragma unroll
            for (int u = 0; u < 32; ++u) {
                const int n = dir == 0 ? (s0 + u) : 127 - (s0 + u);
                const size_t idx = ((size_t)(b * 128 + n) * 32 + g) * 256 + dir * 128 + pp;
                CARRY[idx] = f2bf(fr);
                CARRY[idx + 64] = f2bf(fi);
                const float nr = ar * fr - ai * fi + er[u];
                const float ni = ar * fi + ai * fr + ei[u];
                fr = nr; fi = ni;
            }
        }
    }
}

__device__ __forceinline__ void phase_s5main(const Params& p, int j, unsigned char* lds0, int hb, int wv) {
    const bf16_t* US = (const bf16_t*)(p.ws + OFF_Z + ZE_US);
    const bf16_t* KMAT = (const bf16_t*)(p.ws + OFF_B + B_KMAT);
    const bf16_t* CARRY = (const bf16_t*)(p.ws + OFF_Z + ZE_CARRY);
    bf16_t* YG = (bf16_t*)(p.ws + OFF_B + B_YG);
    const int t512 = t512x();
    for (int t = blockIdx.x; t < 32 * 6 * 4; t += gridDim.x) {
        const int g = t / 24, mt = (t % 24) >> 2, nt = t & 3, m0 = mt * 256, n0 = nt * 256;
        const bf16_t* USg = US + ((size_t)m0 * 32 + g) * 1024;
        const bf16_t* CAg = CARRY + ((size_t)m0 * 32 + g) * 256;
        const bf16_t* KMg = KMAT + ((size_t)g * 1024 + n0) * 1280;
        auto al = [&](int r, int k) {
            if (k < 1024) return USg + (unsigned)(r * 32768 + k);
            return CAg + (unsigned)(r * 8192 + (k - 1024));
        };
        auto bl = [&](int r, int k) { return KMg + (unsigned)(r * 1280 + k); };
        f32x16 acc[2][4];
        zero_acc256(acc);
        gemm256_kloop(acc, al, bl, 20, lds0, t512);
        int tq = t512;
        asm volatile("" : "+v"(tq));
        const int lane = tq & 63, wm = wv >> 1, wn = wv & 1, l31 = lane & 31, half = lane >> 5;
        {
            const unsigned loU = (unsigned)(4 * half * 32768 + l31);
            const unsigned loY = (unsigned)(4 * half * 32768 + (l31 >> 4) * 512 + (l31 & 15));
            const float dsk = p.ssm_d[(size_t)j * 512 + g * 16 + (l31 & 15)];
            bf16_t uv[2][8];
#define S5_LOAD(Q, BUF) { const int mi_ = (Q) >> 3, nj_ = ((Q) >> 1) & 3, hq_ = (Q) & 1; const int nb_ = n0 + wn * 128 + nj_ * 32; \
            _Pragma("unroll") for (int r8 = 0; r8 < 8; ++r8) { const int reg = hq_ * 8 + r8; \
                uv[BUF][r8] = (US + ((size_t)(m0 + ROWU(mi_, reg)) * 32 + g) * 1024 + nb_)[loU]; } }
            S5_LOAD(0, 0);
#pragma unroll
            for (int q = 0; q < 16; ++q) {
                if (q + 1 < 16) S5_LOAD(q + 1, (q + 1) & 1);
                const int mi = q >> 3, nj = (q >> 1) & 3, hq = q & 1;
                const int nb = n0 + wn * 128 + nj * 32;
#pragma unroll
                for (int r8 = 0; r8 < 8; ++r8) {
                    const int reg = hq * 8 + r8;
                    bf16_t* yb = YG + ((size_t)(m0 + ROWU(mi, reg)) * 64 + (nb >> 4)) * 512 + g * 16;
                    yb[loY] = f2bf(gelu_tanh(acc[mi][nj][reg] + dsk * bf2f(uv[q & 1][r8])));
                }
            }
#undef S5_LOAD
        }
    }
}

__device__ __forceinline__ void phase_glu(const Params& p, int j, unsigned char* lds0, int hb, int wv) {
    const bf16_t* Z = (const bf16_t*)(p.ws + OFF_Z);
    bf16_t* OBp = (bf16_t*)(p.ws + OFF_Z + ZE_US);
    const bf16_t* YG = (const bf16_t*)(p.ws + OFF_B + B_YG);
    const bf16_t* Wt = (const bf16_t*)(p.ws + OFF_W) + W_GLU + (size_t)j * 262144;
    const int t512 = t512x();
    for (int t = blockIdx.x; t < 384 * 2; t += gridDim.x) {
        const int mt = t >> 1, nt = t & 1, m0 = mt * 256, n0 = nt * 256;
        const bf16_t* YGm = YG + (size_t)m0 * 512;
        const bf16_t* Wn = Wt + (size_t)n0 * 512;
        auto al = [&](int r, int k) { return YGm + (unsigned)(r * 512 + k); };
        auto bl = [&](int r, int k) { return Wn + (unsigned)(r * 512 + k); };
        f32x16 acc[2][4];
        zero_acc256(acc);
        gemm256_kloop(acc, al, bl, 8, lds0, t512);
        int tq = t512;
        asm volatile("" : "+v"(tq));
        const int lane = tq & 63, wm = wv >> 1, wn = wv & 1, l31 = lane & 31, half = lane >> 5;
        {
            const unsigned loY = (unsigned)(4 * half * 512 + l31), loZ = (unsigned)(4 * half * ZE_LD + l31);
            bf16_t yv[2][8], gv[2][8];
#define GLU_LOAD(Q, BUF) { const int mi_ = (Q) >> 3, nj_ = ((Q) >> 1) & 3, hq_ = (Q) & 1; const int cb_ = n0 + wn * 128 + nj_ * 32; \
            _Pragma("unroll") for (int r8 = 0; r8 < 8; ++r8) { const int reg = hq_ * 8 + r8; \
                yv[BUF][r8] = (YG + (size_t)(m0 + ROWU(mi_, reg)) * 512 + cb_)[loY]; \
                gv[BUF][r8] = (Z + (size_t)(m0 + ROWU(mi_, reg)) * ZE_LD + 1536 + cb_)[loZ]; } }
            GLU_LOAD(0, 0);
#pragma unroll
            for (int q = 0; q < 16; ++q) {
                if (q + 1 < 16) GLU_LOAD(q + 1, (q + 1) & 1);
                const int mi = q >> 3, nj = (q >> 1) & 3, hq = q & 1;
                const int cb = n0 + wn * 128 + nj * 32;
#pragma unroll
                for (int r8 = 0; r8 < 8; ++r8) {
                    const int reg = hq * 8 + r8;
                    (OBp + (size_t)(m0 + ROWU(mi, reg)) * 512 + cb)[loY] = f2bf(bf2f(yv[q & 1][r8]) * sigmoidf_(acc[mi][nj][reg]) * siluf_(bf2f(gv[q & 1][r8])));
                }
            }
#undef GLU_LOAD
        }
    }
}

__device__ __forceinline__ void phase_ret1(const Params& p, unsigned char* lds, int hb, int wv) {
    const bf16_t* VT = (const bf16_t*)(p.ws + OFF_Z + ZE_VT);
    const bf16_t* KT = (const bf16_t*)(p.ws + OFF_Z + ZE_KT);
    bf16_t* ST = (bf16_t*)(p.ws + OFF_B);
    const int tid = tidx();
    const int lane = tid & 63, wave = tid >> 6, wm = wave >> 1, wn = wave & 1, l31 = lane & 31, half = lane >> 5;
    for (int t = VB; t < 2 * 3072; t += VG) {
        const int dir = t / 3072, r3 = t % 3072, b = r3 / 256, n = (r3 >> 2) & 63, h = r3 & 3;
        const float l2g = log2_gamma(h);
        const bf16_t* vt = VT + ((size_t)(b * 4 + h) * 128) * SEQL + n * 128;
        const bf16_t* kt = KT + ((size_t)(b * 4 + h) * 128) * SEQL + n * 128;
        auto al = [&](int r, int k) {
            const uint4 v = *(const uint4*)(vt + (size_t)r * SEQL + k);
            float w[8];
#pragma unroll
            for (int e = 0; e < 8; ++e) w[e] = __builtin_amdgcn_exp2f(l2g * (dir == 0 ? (float)(128 - (k + e)) : (float)(k + e + 1)));
            uint4 o;
            o.x = pk2(__uint_as_float(v.x << 16) * w[0], __uint_as_float(v.x & 0xffff0000u) * w[1]);
            o.y = pk2(__uint_as_float(v.y << 16) * w[2], __uint_as_float(v.y & 0xffff0000u) * w[3]);
            o.z = pk2(__uint_as_float(v.z << 16) * w[4], __uint_as_float(v.z & 0xffff0000u) * w[5]);
            o.w = pk2(__uint_as_float(v.w << 16) * w[6], __uint_as_float(v.w & 0xffff0000u) * w[7]);
            return o;
        };
        auto bl = [&](int r, int k) { return *(const uint4*)(kt + (size_t)r * SEQL + k); };
        f32x16 acc[2][2];
        zero_acc(acc);
        gemm_kloop(acc, al, bl, 2, lds, tid);
        bf16_t* st = ST + ((((size_t)dir * 12 + b) * 64 + n) * 4 + h) * 16384;
#pragma unroll
        for (int mi = 0; mi < 2; ++mi) {
            const int e = wm * 64 + mi * 32 + l31;
#pragma unroll
            for (int nj = 0; nj < 2; ++nj)
#pragma unroll
                for (int q4 = 0; q4 < 4; ++q4) {
                    const int d = wn * 32 + nj * 64 + 8 * q4 + 4 * half;
                    st4(st + e * 128 + d, acc[mi][nj][4 * q4], acc[mi][nj][4 * q4 + 1], acc[mi][nj][4 * q4 + 2], acc[mi][nj][4 * q4 + 3]);
                }
        }
    }
}

__device__ __forceinline__ void phase_ret2(const Params& p, int hb, int wv) {
    bf16_t* ST = (bf16_t*)(p.ws + OFF_B);
    for (int it = VB * 256 + tidx(); it < 2 * 12 * 4 * 2048; it += VG * 256) {
        const int v = it & 2047, h = (it >> 11) & 3, bd = it >> 13;
        const int dir = bd / 12;
        const float dec = exp2f(128.f * log2_gamma(h));
        float c[8];
#pragma unroll
        for (int e = 0; e < 8; ++e) c[e] = 0.f;
#pragma unroll 1
        for (int s0 = 0; s0 < 64; s0 += 16) {
            uint4 kvv[16];
#pragma unroll
            for (int u = 0; u < 16; ++u) {
                const int n = dir == 0 ? (s0 + u) : 63 - (s0 + u);
                kvv[u] = *(const uint4*)(ST + (((size_t)bd * 64 + n) * 4 + h) * 16384 + v * 8);
            }
#pragma unroll
            for (int u = 0; u < 16; ++u) {
                const int n = dir == 0 ? (s0 + u) : 63 - (s0 + u);
                bf16_t* ptr = ST + (((size_t)bd * 64 + n) * 4 + h) * 16384 + v * 8;
                const uint4 kv = kvv[u];
                uint4 o;
                o.x = pk2(c[0], c[1]); o.y = pk2(c[2], c[3]); o.z = pk2(c[4], c[5]); o.w = pk2(c[6], c[7]);
                *(uint4*)ptr = o;
                c[0] = dec * c[0] + __uint_as_float(kv.x << 16); c[1] = dec * c[1] + __uint_as_float(kv.x & 0xffff0000u);
                c[2] = dec * c[2] + __uint_as_float(kv.y << 16); c[3] = dec * c[3] + __uint_as_float(kv.y & 0xffff0000u);
                c[4] = dec * c[4] + __uint_as_float(kv.z << 16); c[5] = dec * c[5] + __uint_as_float(kv.z & 0xffff0000u);
                c[6] = dec * c[6] + __uint_as_float(kv.w << 16); c[7] = dec * c[7] + __uint_as_float(kv.w & 0xffff0000u);
            }
        }
    }
}

__device__ __forceinline__ void phase_ret3(const Params& p, unsigned char* lds, int hb, int wv) {
    bf16_t* Z = (bf16_t*)(p.ws + OFF_Z);
    const bf16_t* VT = (const bf16_t*)(p.ws + OFF_Z + ZE_VT);
    const bf16_t* ST = (const bf16_t*)(p.ws + OFF_B);
    float2* stat = (float2*)(lds + 4 * STAGE_B);
    const int tid = tidx();
    const int lane = tid & 63, wave = tid >> 6, wm = wave >> 1, wn = wave & 1, l31 = lane & 31, half = lane >> 5;
    for (int t = VB; t < 3072; t += VG) {
        const int b = t / 256, n = (t >> 2) & 63, h = t & 3;
        const float l2g = log2_gamma(h);
        const size_t m0 = (size_t)b * SEQL + n * 128;
        const bf16_t* zq = Z + m0 * ZE_LD + h * 128;
        const bf16_t* zk = Z + m0 * ZE_LD + 512 + h * 128;
        const bf16_t* stf = ST + ((((size_t)0 * 12 + b) * 64 + n) * 4 + h) * 16384;
        const bf16_t* stb = ST + ((((size_t)1 * 12 + b) * 64 + n) * 4 + h) * 16384;
        const bf16_t* vt = VT + ((size_t)(b * 4 + h) * 128) * SEQL + n * 128;
        f32x16 acc[2][2], accS[2][2];
        zero_acc(accS);
        {
            auto al = [&](int r, int k) { return *(const uint4*)(zq + (size_t)r * ZE_LD + k); };
            auto bl = [&](int r, int k) { return *(const uint4*)(zk + (size_t)r * ZE_LD + k); };
            gemm_kloop1(accS, al, bl, 2, lds, tid);
        }
        float l2gp = l2g;
        asm volatile("" : "+v"(l2gp));
        int l31p = l31;
        asm volatile("" : "+v"(l31p));
#pragma unroll
        for (int mi = 0; mi < 2; ++mi) {
            const int i = wm * 64 + mi * 32 + l31p;
#pragma unroll
            for (int nj = 0; nj < 2; ++nj)
#pragma unroll
                for (int q4 = 0; q4 < 4; ++q4) {
                    const int jj = wn * 32 + nj * 64 + 8 * q4 + 4 * half;
                    float pv[4];
#pragma unroll
                    for (int r = 0; r < 4; ++r) {
                        const int dj = i - (jj + r);
                        pv[r] = accS[mi][nj][4 * q4 + r] * __builtin_amdgcn_exp2f(l2gp * (float)(dj < 0 ? -dj : dj));
                    }
                    uint2 o; o.x = pk2(pv[0], pv[1]); o.y = pk2(pv[2], pv[3]);
                    *(uint2*)(lds + (jj >> 6) * STAGE_B + i * LDS_PITCH + (jj & 63) * 2) = o;
                }
        }
        __builtin_amdgcn_sched_barrier(0);
        {
            const int srow = tid >> 3, skc = (tid & 7) * 8;
#pragma unroll
            for (int kt = 0; kt < 2; ++kt) {
                uint4 v[4];
#pragma unroll
                for (int i = 0; i < 4; ++i) v[i] = *(const uint4*)(vt + (size_t)(srow + 32 * i) * SEQL + kt * 64 + skc);
#pragma unroll
                for (int i = 0; i < 4; ++i) *(uint4*)(lds + 2 * STAGE_B + kt * STAGE_B + (srow + 32 * i) * LDS_PITCH + skc * 2) = v[i];
                __builtin_amdgcn_sched_barrier(0);
            }
        }
        __syncthreads();
        zero_acc(acc);
        compute_ktile(acc, lds, lds + 2 * STAGE_B, tid, true);
        compute_ktile(acc, lds + STAGE_B, lds + 3 * STAGE_B, tid, true);
#pragma unroll 1
        for (int dirsel = 0; dirsel < 2; ++dirsel) {
            const bf16_t* stp = dirsel == 0 ? stf : stb;
            auto al = [&](int r, int k) {
                const uint4 v = *(const uint4*)(zq + (size_t)r * ZE_LD + k);
                const float s = __builtin_amdgcn_exp2f(l2g * (dirsel == 0 ? (float)r : (float)(127 - r)));
                return scale8(v, s);
            };
            auto bl = [&](int r, int k) { return *(const uint4*)(stp + r * 128 + k); };
            gemm_kloop1(acc, al, bl, 2, lds, tid);
        }
        float s1[2], s2[2];
#pragma unroll
        for (int mi = 0; mi < 2; ++mi) {
            float a = 0.f, q = 0.f;
#pragma unroll
            for (int nj = 0; nj < 2; ++nj)
#pragma unroll
                for (int e = 0; e < 16; ++e) { const float v = acc[mi][nj][e]; a += v; q += v * v; }
            a += __shfl_xor(a, 32); q += __shfl_xor(q, 32);
            s1[mi] = a; s2[mi] = q;
            if (half == 0) stat[(wm * 64 + mi * 32 + l31) * 2 + wn] = make_float2(a, q);
        }
        __syncthreads();
#pragma unroll
        for (int mi = 0; mi < 2; ++mi) {
            const int i = wm * 64 + mi * 32 + l31;
            const float2 o = stat[i * 2 + (wn ^ 1)];
            const float mean = (s1[mi] + o.x) * (1.f / 128.f);
            const float var = (s2[mi] + o.y) * (1.f / 128.f) - mean * mean;
            const float rstd = rsqrtf(fmaxf(var, 0.f) + EPSF);
            bf16_t* zr = Z + (m0 + i) * ZE_LD;
            float gg[2][4][4];
#pragma unroll
            for (int nj = 0; nj < 2; ++nj)
#pragma unroll
                for (int q4 = 0; q4 < 4; ++q4) {
                    const int e = wn * 32 + nj * 64 + 8 * q4 + 4 * half;
                    ld4(zr + 1024 + h * 128 + e, gg[nj][q4][0], gg[nj][q4][1], gg[nj][q4][2], gg[nj][q4][3]);
                }
#pragma unroll
            for (int nj = 0; nj < 2; ++nj)
#pragma unroll
                for (int q4 = 0; q4 < 4; ++q4) {
                    const int e = wn * 32 + nj * 64 + 8 * q4 + 4 * half;
                    st4(zr + h * 128 + e,
                        (acc[mi][nj][4 * q4] - mean) * rstd * siluf_(gg[nj][q4][0]), (acc[mi][nj][4 * q4 + 1] - mean) * rstd * siluf_(gg[nj][q4][1]),
                        (acc[mi][nj][4 * q4 + 2] - mean) * rstd * siluf_(gg[nj][q4][2]), (acc[mi][nj][4 * q4 + 3] - mean) * rstd * siluf_(gg[nj][q4][3]));
                }
        }
        __syncthreads();
    }
}

__device__ __forceinline__ void phase_na(const Params& p, int j, unsigned char* lds, int hb, int wv) {
    bf16_t* Z = (bf16_t*)(p.ws + OFF_Z);
    const bf16_t* VT = (const bf16_t*)(p.ws + OFF_Z + ZO_VT);
    float* btab = (float*)(lds + 4 * STAGE_B);
    const int tid = tidx();
    const int lane = tid & 63, a = tid >> 6;
    const int l15 = lane & 15, g = lane >> 4;
    const int kw = (a == 0) ? 0 : (a == 1) ? 8 : (a == 2) ? 24 : 32;
    const int cq = a * 16 + l15;
    int cs = cq - 8; cs = cs < 0 ? 0 : (cs > 48 ? 48 : cs);
    const int srow = tid >> 3, sc8 = (tid & 7) * 8;
    const unsigned koff = (unsigned)(srow * ZO_LD + sc8), voff = (unsigned)(srow * SEQL + sc8);
    const bool xmap = (gridDim.x == 256);
    const int RPB = xmap ? 2 : 16;
    for (int it = 0;; ++it) {
        if (xmap && it >= 24) break;
        int bh, r0;
        if (xmap) { bh = it * 8 + (blockIdx.x & 7); r0 = ((blockIdx.x >> 3) * 2 + hb) * RPB; }
        else { const int c = it * VG + VB; if (c >= 192 * 8) break; bh = c >> 3; r0 = (c & 7) * 16; }
        const int b = bh >> 4, h = bh & 15;
        __syncthreads();
        for (int i = tid; i < 15 * 32; i += 256) {
            const int rr = i >> 5, cc = i & 31;
            btab[i] = cc < 31 ? p.rel_bias[(((size_t)j * 16 + h) * 15 + rr) * 31 + cc] : 0.f;
        }
        const bf16_t* vtb = VT + ((size_t)(b * 16 + h) * 64) * SEQL;
#pragma unroll 1
        for (int r = r0; r < r0 + RPB; ++r) {
            int rs = r - 4; rs = rs < 0 ? 0 : (rs > 120 ? 120 : rs);
            const size_t tokq = (size_t)b * SEQL + r * 64 + cq;
            bf16_t* zq = Z + tokq * ZO_LD + h * 64;
            u32x4 st[16];
            {
                const bf16_t* kbase = Z + ((size_t)b * SEQL + rs * 64) * ZO_LD + 1024 + h * 64;
#pragma unroll
                for (int i = 0; i < 16; ++i) st[i] = *(const u32x4*)(kbase + (size_t)(32 * i) * ZO_LD + koff);
            }
            const bf16x8 q0 = *(const bf16x8*)(zq + g * 8);
            const bf16x8 q1 = *(const bf16x8*)(zq + 32 + g * 8);
            __syncthreads();
#pragma unroll
            for (int i = 0; i < 16; ++i) *(u32x4*)(lds + (srow + 32 * i) * LDS_PITCH + sc8 * 2) = st[i];
            __syncthreads();
            f32x4 S[8][2];
#pragma unroll
            for (int kr = 0; kr < 8; ++kr) {
                const float* rbr = btab + (rs + kr - r + 7) * 32;
#pragma unroll
                for (int kb = 0; kb < 2; ++kb) {
                    const unsigned char* kp = lds + (kr * 64 + kw + kb * 16 + l15) * LDS_PITCH + g * 16;
                    const bf16x8 k0 = *(const bf16x8*)kp;
                    const bf16x8 k1 = *(const bf16x8*)(kp + 64);
                    f32x4 s = {0.f, 0.f, 0.f, 0.f};
                    s = __builtin_amdgcn_mfma_f32_16x16x32_bf16(k0, q0, s, 0, 0, 0);
                    s = __builtin_amdgcn_mfma_f32_16x16x32_bf16(k1, q1, s, 0, 0, 0);
#pragma unroll
                    for (int e = 0; e < 4; ++e) {
                        const int kc = kw + kb * 16 + 4 * g + e;
                        int dc = kc - cq + 15; dc = dc < 0 ? 0 : (dc > 30 ? 30 : dc);
                        const bool valid = (kc >= cs) && (kc < cs + 16);
                        s[e] = valid ? s[e] + rbr[dc] : -1e30f;
                    }
                    S[kr][kb] = s;
                }
            }
            u32x4 sv[16];
            const bf16_t* vbase = vtb + rs * 64;
#pragma unroll
            for (int i = 0; i < 8; ++i) {
                sv[i] = *(const u32x4*)(vbase + (size_t)(32 * (i & 1)) * SEQL + (i >> 1) * 64 + voff);
            }
            float mx = -1e30f;
#pragma unroll
            for (int kr = 0; kr < 8; ++kr)
#pragma unroll
                for (int kb = 0; kb < 2; ++kb)
#pragma unroll
                    for (int e = 0; e < 4; ++e) mx = fmaxf(mx, S[kr][kb][e]);
            mx = fmaxf(mx, __shfl_xor(mx, 16));
            mx = fmaxf(mx, __shfl_xor(mx, 32));
            const float nmxl = -mx * 1.4426950408889634f;
            float sum = 0.f;
            u32x4 P[8];
#pragma unroll
            for (int kr = 0; kr < 8; ++kr) {
                float ev[8];
#pragma unroll
                for (int kb = 0; kb < 2; ++kb)
#pragma unroll
                    for (int e = 0; e < 4; ++e) { ev[kb * 4 + e] = __builtin_amdgcn_exp2f(fmaf(S[kr][kb][e], 1.4426950408889634f, nmxl)); sum += ev[kb * 4 + e]; }
                P[kr].x = pk2(ev[0], ev[1]); P[kr].y = pk2(ev[2], ev[3]); P[kr].z = pk2(ev[4], ev[5]); P[kr].w = pk2(ev[6], ev[7]);
            }
#pragma unroll
            for (int i = 8; i < 16; ++i) {
                sv[i] = *(const u32x4*)(vbase + (size_t)(32 * (i & 1)) * SEQL + (i >> 1) * 64 + voff);
            }
            sum += __shfl_xor(sum, 16);
            sum += __shfl_xor(sum, 32);
            const float rinv = 1.f / sum;
            __syncthreads();
#pragma unroll
            for (int i = 0; i < 16; ++i) *(u32x4*)(lds + (srow + 32 * i) * LDS_PITCH + sc8 * 2) = sv[i];
            __syncthreads();
            f32x4 O[4];
#pragma unroll
            for (int blk = 0; blk < 4; ++blk) O[blk] = (f32x4){0.f, 0.f, 0.f, 0.f};
#pragma unroll
            for (int kr = 0; kr < 8; ++kr) {
                const bf16x8 pf = (bf16x8)P[kr];
#pragma unroll
                for (int blk = 0; blk < 4; ++blk) {
                    const unsigned char* vp = lds + (kr * 64 + blk * 16 + l15) * LDS_PITCH + (kw + 4 * g) * 2;
                    const uint2 lo = *(const uint2*)vp;
                    const uint2 hi = *(const uint2*)(vp + 32);
                    u32x4 vu; vu.x = lo.x; vu.y = lo.y; vu.z = hi.x; vu.w = hi.y;
                    O[blk] = __builtin_amdgcn_mfma_f32_16x16x32_bf16((bf16x8)vu, pf, O[blk], 0, 0, 0);
                }
            }
            const bf16_t* zg = Z + tokq * ZO_LD + 2048 + h * 64;
            float go[4][4];
#pragma unroll
            for (int blk = 0; blk < 4; ++blk) ld4(zg + blk * 16 + 4 * g, go[blk][0], go[blk][1], go[blk][2], go[blk][3]);
#pragma unroll
            for (int blk = 0; blk < 4; ++blk) {
                const int dh = blk * 16 + 4 * g;
                st4(zq + dh, O[blk][0] * rinv * siluf_(go[blk][0]), O[blk][1] * rinv * siluf_(go[blk][1]), O[blk][2] * rinv * siluf_(go[blk][2]), O[blk][3] * rinv * siluf_(go[blk][3]));
            }
        }
    }
}

constexpr int N_PHASES = 32;
__device__ __forceinline__ void run_phase(const Params& p, int ph, unsigned char* lds, unsigned char* lds0, int hb, int wv) {
    if (ph >= 100) return;
    if (ph == 0) { phase_prologue(p, lds, hb, wv); return; }
    if (ph == 31) { phase_norm(p, 4, hb, wv); return; }
    int q = ph - 1;
    const int pair = q / 15; q %= 15;
    if (q < 11) {
        const int L = pair * 2, j = pair;
        switch (q) {
            case 0: phase_norm(p, L, hb, wv); break;
            case 1: phase_inproj_even(p, j, lds0, hb, wv); break;
            case 2: phase_s5consts(p, j, lds, hb, wv); break;
            case 3: phase_s5A(p, lds0, hb, wv); break;
            case 4: phase_s5scan(p, j, hb, wv); break;
            case 5: phase_s5main(p, j, lds0, hb, wv); break;
            case 6: phase_glu(p, j, lds0, hb, wv); break;
            case 7: phase_ret1(p, lds, hb, wv); break;
            case 8: phase_ret2(p, hb, wv); break;
            case 9: phase_ret3(p, lds, hb, wv); break;
            default: phase_outproj(p, L, lds0, hb, wv); break;
        }
    } else {
        const int L = pair * 2 + 1, j = pair;
        switch (q - 11) {
            case 0: phase_norm(p, L, hb, wv); break;
            case 1: phase_inproj_odd(p, j, lds0, hb, wv); break;
            case 2: phase_na(p, j, lds, hb, wv); break;
            default: phase_outproj(p, L, lds0, hb, wv); break;
        }
    }
}

#ifndef PROBE_PH
#define PROBE_PH 0
#define PROBE_N 0
#endif
__device__ __forceinline__ void grid_barrier(unsigned* ctr, unsigned target, int wv) {
    asm volatile("s_waitcnt vmcnt(0)" ::: "memory");
    __syncthreads();
    if (wv == 0 && lane_id() == 0) {
        __builtin_amdgcn_fence(__ATOMIC_RELEASE, "agent");
        asm volatile("s_waitcnt vmcnt(0)" ::: "memory");
        __hip_atomic_fetch_add(ctr, 1u, __ATOMIC_RELAXED, __HIP_MEMORY_SCOPE_AGENT);
        while (__hip_atomic_load(ctr, __ATOMIC_RELAXED, __HIP_MEMORY_SCOPE_AGENT) < target) { }
        __builtin_amdgcn_fence(__ATOMIC_ACQUIRE, "agent");
        asm volatile("s_waitcnt vmcnt(0)" ::: "memory");
    }
    __syncthreads();
}

__global__ void __launch_bounds__(512, 2) fwd_megakernel(Params p_in, int n_extra, int probe_ph) {
    __shared__ __attribute__((aligned(16))) unsigned char lds_all[2 * LDS_TOTAL];
    const Params& p = p_in;
    const int wv = __builtin_amdgcn_readfirstlane((int)(threadIdx.x >> 6));
    const int hb = wv >> 2;
    unsigned char* lds = lds_all + hb * LDS_TOTAL;
    cg::grid_group grid = cg::this_grid();
    unsigned* bar = (unsigned*)(p.ws + OFF_BAR);
    if (blockIdx.x == 0 && threadIdx.x == 0) __hip_atomic_store(bar, 0u, __ATOMIC_RELAXED, __HIP_MEMORY_SCOPE_AGENT);
    const int total = N_PHASES + n_extra;
#pragma unroll 1
    for (int it = 0; it < total; ++it) {
        const int ph = it < N_PHASES ? it : probe_ph + (it - N_PHASES);
        run_phase(p, ph, lds, lds_all, hb, wv);
        if (it + 1 < total) {
            if (it == 0) grid.sync();
            else grid_barrier(bar, (unsigned)it * gridDim.x, wv);
        }
    }
}

extern "C" void kernel_launch(void* const* d_in, const int* in_sizes, int n_in, void* d_out, int out_size, void* d_ws, size_t ws_size,
                              hipStream_t stream) {
    static int grid_blocks = 0;
    if (!grid_blocks) {
        int dev = 0, cus = 0, per_cu = 0;
        hipGetDevice(&dev);
        hipDeviceGetAttribute(&cus, hipDeviceAttributeMultiprocessorCount, dev);
        hipOccupancyMaxActiveBlocksPerMultiprocessor(&per_cu, fwd_megakernel, 512, 0);
        if (per_cu < 1) per_cu = 1;
        if (per_cu > 1) per_cu = 1;
        grid_blocks = cus * per_cu;
    }
    Params p{};
    p.x_prompt = (const float*)d_in[0]; p.x_sample = (const float*)d_in[1]; p.c_prompt = (const float*)d_in[2]; p.c_sample = (const float*)d_in[3];
    p.norm_pre = (const float*)d_in[4]; p.norm_post = (const float*)d_in[5]; p.w_mod = (const float*)d_in[6]; p.b_mod = (const float*)d_in[7];
    p.w_in_ab = (const float*)d_in[8]; p.w_out_ab = (const float*)d_in[9]; p.a_re = (const float*)d_in[10]; p.a_im = (const float*)d_in[11];
    p.log_step = (const float*)d_in[12]; p.b_re = (const float*)d_in[13]; p.b_im = (const float*)d_in[14]; p.c_re = (const float*)d_in[15];
    p.c_im = (const float*)d_in[16]; p.ssm_d = (const float*)d_in[17]; p.w_glu = (const float*)d_in[18]; p.w_in_c = (const float*)d_in[19];
    p.w_out_c = (const float*)d_in[20]; p.rel_bias = (const float*)d_in[21];
    p.out = (float*)d_out; p.ws = (unsigned char*)d_ws;
    int n_extra = PROBE_N, probe_ph = PROBE_PH;
    void* args[] = {&p, &n_extra, &probe_ph};
    hipError_t e = hipLaunchCooperativeKernel((void*)fwd_megakernel, dim3(grid_blocks), dim3(512), args, 0, stream);
    if (e != hipSuccess) fprintf(stderr, "cooperative launch failed: %s (grid %d)\n", hipGetErrorString(e), grid_blocks);
}
```

```cpp
#include <hip/hip_runtime.h>
#include <hip/hip_cooperative_groups.h>
#include <cstdio>
#include <cstdint>
namespace cg = cooperative_groups;

typedef unsigned short bf16_t;
typedef short bf16x8 __attribute__((ext_vector_type(8)));
typedef float f32x4 __attribute__((ext_vector_type(4)));
typedef float f32x16 __attribute__((ext_vector_type(16)));
typedef unsigned u32x4 __attribute__((ext_vector_type(4)));

constexpr int T_TOK = 98304, SEQL = 8192, DM = 1024;
constexpr float EPSF = 1e-6f;

constexpr size_t OFF_Z = 0;
constexpr size_t SZ_Z = 805306368ull;
constexpr size_t OFF_B = OFF_Z + SZ_Z;
constexpr size_t SZ_B = 201326592ull;
constexpr size_t OFF_W = OFF_B + SZ_B;
constexpr size_t W_IN_AB = 0;
constexpr size_t W_OUT_AB = W_IN_AB + 2ull * 3145728;
constexpr size_t W_GLU = W_OUT_AB + 2ull * 1048576;
constexpr size_t W_IN_C = W_GLU + 2ull * 262144;
constexpr size_t W_OUT_C = W_IN_C + 2ull * 4194304;
constexpr size_t W_TOTAL = W_OUT_C + 2ull * 1048576;
constexpr size_t OFF_MOD = OFF_W + W_TOTAL * 2;
constexpr size_t OFF_COS = OFF_MOD + 4ull * 12 * 3072 * 4;
constexpr size_t OFF_SIN = OFF_COS + 8192ull * 64 * 4;
constexpr size_t WS_END = OFF_SIN + 8192ull * 64 * 4;
constexpr size_t OFF_BAR = WS_END;
constexpr int ZE_LD = 2048;
constexpr size_t ZE_US = (size_t)T_TOK * ZE_LD * 2;
constexpr size_t ZE_VT = ZE_US + 100663296ull;
constexpr size_t ZE_KT = ZE_VT + 100663296ull;
constexpr size_t ZE_E = ZE_KT + 100663296ull;
constexpr size_t ZE_CARRY = ZE_E + 50331648ull;
constexpr int ZO_LD = 3072;
constexpr size_t ZO_VT = (size_t)T_TOK * ZO_LD * 2;
constexpr size_t B_YG = 0;
constexpr size_t B_KMAT = 100663296ull;
constexpr size_t B_EMAT = B_KMAT + 83886080ull;

struct Params {
    const float *x_prompt, *x_sample, *c_prompt, *c_sample, *norm_pre, *norm_post, *w_mod, *b_mod;
    const float *w_in_ab, *w_out_ab, *a_re, *a_im, *log_step, *b_re, *b_im, *c_re, *c_im, *ssm_d, *w_glu;
    const float *w_in_c, *w_out_c, *rel_bias;
    float* out;
    unsigned char* ws;
    int hb;
    int pad_;
};

__device__ __forceinline__ float bf2f(unsigned short u) { return __uint_as_float(((unsigned)u) << 16); }
__device__ __forceinline__ unsigned pk2(float lo, float hi) {
    unsigned r;
    asm("v_cvt_pk_bf16_f32 %0, %1, %2" : "=v"(r) : "v"(lo), "v"(hi));
    return r;
}
__device__ __forceinline__ bf16_t f2bf(float v) { return (bf16_t)(pk2(v, 0.f) & 0xffffu); }
__device__ __forceinline__ float sigmoidf_(float x) { return __builtin_amdgcn_rcpf(1.f + __expf(-x)); }
__device__ __forceinline__ float siluf_(float x) { return x * __builtin_amdgcn_rcpf(1.f + __expf(-x)); }
__device__ __forceinline__ float gelu_tanh(float y) {
    const float u = 0.7978845608028654f * (y + 0.044715f * y * y * y);
    const float e = __expf(2.f * u);
    const float th = 1.f - 2.f * __builtin_amdgcn_rcpf(e + 1.f);
    return 0.5f * y * (1.f + th);
}
__device__ __forceinline__ void st4(bf16_t* dst, float a, float b, float c, float d) {
    uint2 v; v.x = pk2(a, b); v.y = pk2(c, d);
    *(uint2*)dst = v;
}
__device__ __forceinline__ void ld4(const bf16_t* src, float& a, float& b, float& c, float& d) {
    const uint2 v = *(const uint2*)src;
    a = __uint_as_float(v.x << 16); b = __uint_as_float(v.x & 0xffff0000u);
    c = __uint_as_float(v.y << 16); d = __uint_as_float(v.y & 0xffff0000u);
}
__device__ __forceinline__ uint4 scale8(uint4 v, float s) {
    uint4 o;
    o.x = pk2(__uint_as_float(v.x << 16) * s, __uint_as_float(v.x & 0xffff0000u) * s);
    o.y = pk2(__uint_as_float(v.y << 16) * s, __uint_as_float(v.y & 0xffff0000u) * s);
    o.z = pk2(__uint_as_float(v.z << 16) * s, __uint_as_float(v.z & 0xffff0000u) * s);
    o.w = pk2(__uint_as_float(v.w << 16) * s, __uint_as_float(v.w & 0xffff0000u) * s);
    return o;
}
__device__ __forceinline__ const float* x_row(const Params& p, int row) {
    return row < 4 * SEQL ? p.x_prompt + (size_t)row * DM : p.x_sample + (size_t)(row - 4 * SEQL) * DM;
}
__device__ __forceinline__ const float* c_row(const Params& p, int b) {
    return b < 4 ? p.c_prompt + (size_t)b * DM : p.c_sample + (size_t)(b - 4) * DM;
}
__device__ __forceinline__ float log2_gamma(int h) { return log2f(1.f - exp2f(-5.f - (float)h)); }

__device__ __forceinline__ int lane_id() { int l; asm volatile("v_mbcnt_lo_u32_b32 %0, -1, 0\n\tv_mbcnt_hi_u32_b32 %0, -1, %0" : "=v"(l)); return l; }
#define tidx() tid_of(wv & 3)
#define t512x() tid_of(wv)
__device__ __forceinline__ int tid_of(int w) { int t = w * 64 + lane_id(); asm volatile("" : "+v"(t)); return t; }
#define VB ((int)blockIdx.x * 2 + hb)
#define VG ((int)gridDim.x * 2)
constexpr int LDS_PITCH = 144;
constexpr int STAGE_B = 128 * LDS_PITCH;
constexpr int LDS_TOTAL = 4 * STAGE_B + 2048;

__device__ __forceinline__ void compute_ktile(f32x16 (&acc)[2][2], const unsigned char* Ab, const unsigned char* Bb, int tid, bool swap) {
    const int lane = tid & 63, wave = tid >> 6, wm = wave >> 1, wn = wave & 1;
    const int l31 = lane & 31, half = lane >> 5;
    const unsigned char* ap = Ab + (wm * 64 + l31) * LDS_PITCH + half * 16;
    const unsigned char* bp = Bb + (wn * 32 + l31) * LDS_PITCH + half * 16;
    if (swap) {
#pragma unroll
        for (int ks = 0; ks < 4; ++ks) {
            bf16x8 a[2], b[2];
            a[0] = *(const bf16x8*)(ap + ks * 32);
            a[1] = *(const bf16x8*)(ap + 32 * LDS_PITCH + ks * 32);
            b[0] = *(const bf16x8*)(bp + ks * 32);
            b[1] = *(const bf16x8*)(bp + 64 * LDS_PITCH + ks * 32);
#pragma unroll
            for (int mi = 0; mi < 2; ++mi)
#pragma unroll
                for (int nj = 0; nj < 2; ++nj) acc[mi][nj] = __builtin_amdgcn_mfma_f32_32x32x16_bf16(b[nj], a[mi], acc[mi][nj], 0, 0, 0);
        }
    } else {
#pragma unroll
        for (int ks = 0; ks < 4; ++ks) {
            bf16x8 a[2], b[2];
            a[0] = *(const bf16x8*)(ap + ks * 32);
            a[1] = *(const bf16x8*)(ap + 32 * LDS_PITCH + ks * 32);
            b[0] = *(const bf16x8*)(bp + ks * 32);
            b[1] = *(const bf16x8*)(bp + 64 * LDS_PITCH + ks * 32);
#pragma unroll
            for (int mi = 0; mi < 2; ++mi)
#pragma unroll
                for (int nj = 0; nj < 2; ++nj) acc[mi][nj] = __builtin_amdgcn_mfma_f32_32x32x16_bf16(a[mi], b[nj], acc[mi][nj], 0, 0, 0);
        }
    }
}

template <class AL, class BL>
__device__ __forceinline__ void gemm_kloop1(f32x16 (&acc)[2][2], const AL& al, const BL& bl, int nk, unsigned char* lds, int tid, bool swap = true) {
    const int srow = tid >> 3, skc = (tid & 7) * 8;
    uint4 ra[4], rb[4];
#pragma unroll
    for (int i = 0; i < 4; ++i) { ra[i] = al(srow + 32 * i, skc); rb[i] = bl(srow + 32 * i, skc); }
    __syncthreads();
#pragma unroll
    for (int i = 0; i < 4; ++i) {
        *(uint4*)(lds + (srow + 32 * i) * LDS_PITCH + skc * 2) = ra[i];
        *(uint4*)(lds + 2 * STAGE_B + (srow + 32 * i) * LDS_PITCH + skc * 2) = rb[i];
    }
    __syncthreads();
#pragma unroll 1
    for (int kt = 0; kt < nk; ++kt) {
        const int cur = kt & 1;
        const bool more = (kt + 1 < nk);
        if (more) {
            const int k = (kt + 1) * 64 + skc;
#pragma unroll
            for (int i = 0; i < 4; ++i) { ra[i] = al(srow + 32 * i, k); rb[i] = bl(srow + 32 * i, k); }
        }
        compute_ktile(acc, lds + cur * STAGE_B, lds + 2 * STAGE_B + cur * STAGE_B, tid, swap);
        if (more) {
            const int nxt = cur ^ 1;
#pragma unroll
            for (int i = 0; i < 4; ++i) {
                *(uint4*)(lds + nxt * STAGE_B + (srow + 32 * i) * LDS_PITCH + skc * 2) = ra[i];
                *(uint4*)(lds + 2 * STAGE_B + nxt * STAGE_B + (srow + 32 * i) * LDS_PITCH + skc * 2) = rb[i];
            }
        }
        __syncthreads();
    }
}

template <class AL, class BL>
__device__ __forceinline__ void gemm_kloop(f32x16 (&acc)[2][2], const AL& al, const BL& bl, int nk, unsigned char* lds, int tid, bool swap = true) {
    const int srow = tid >> 3, skc = (tid & 7) * 8;
    uint4 ra0[4], rb0[4], ra1[4], rb1[4];
#define GK_LOAD(RA, RB, KT) { const int k_ = (KT) * 64 + skc; _Pragma("unroll") for (int i = 0; i < 4; ++i) { RA[i] = al(srow + 32 * i, k_); RB[i] = bl(srow + 32 * i, k_); } }
#define GK_STORE(RA, RB, BUF) { _Pragma("unroll") for (int i = 0; i < 4; ++i) { \
        *(uint4*)(lds + (BUF) * STAGE_B + (srow + 32 * i) * LDS_PITCH + skc * 2) = RA[i]; \
        *(uint4*)(lds + 2 * STAGE_B + (BUF) * STAGE_B + (srow + 32 * i) * LDS_PITCH + skc * 2) = RB[i]; } }
    const int last = nk - 1;
    GK_LOAD(ra0, rb0, 0);
    GK_LOAD(ra1, rb1, 1);
    __syncthreads();
    GK_STORE(ra0, rb0, 0);
    GK_LOAD(ra0, rb0, (2 < last ? 2 : last));
    __syncthreads();
#pragma unroll 1
    for (int kt = 0; kt < nk; kt += 2) {
        compute_ktile(acc, lds, lds + 2 * STAGE_B, tid, swap);
        GK_STORE(ra1, rb1, 1);
        __builtin_amdgcn_sched_barrier(0);
        GK_LOAD(ra1, rb1, (kt + 3 < last ? kt + 3 : last));
        __syncthreads();
        compute_ktile(acc, lds + STAGE_B, lds + 3 * STAGE_B, tid, swap);
        GK_STORE(ra0, rb0, 0);
        __builtin_amdgcn_sched_barrier(0);
        GK_LOAD(ra0, rb0, (kt + 4 < last ? kt + 4 : last));
        __syncthreads();
    }
#undef GK_LOAD
#undef GK_STORE
}

constexpr int ST2_B = 65536;
__device__ __forceinline__ void compute_ktile256(f32x16 (&acc)[2][4], const unsigned char* Ab, const unsigned char* Bb, int t512) {
    const int lane = t512 & 63, wave = t512 >> 6, wm = wave >> 1, wn = wave & 1;
    const int l31 = lane & 31, half = lane >> 5;
    const int swz = (l31 >> 1) & 7;
    const unsigned char* ap = Ab + (wm * 64 + l31) * 128;
    const unsigned char* bp = Bb + (wn * 128 + l31) * 128;
#pragma unroll
    for (int ks = 0; ks < 4; ++ks) {
        const int off = ((ks * 2 + half) ^ swz) * 16;
        bf16x8 a[2], b[4];
        a[0] = *(const bf16x8*)(ap + off);
        a[1] = *(const bf16x8*)(ap + 32 * 128 + off);
#pragma unroll
        for (int nj = 0; nj < 4; ++nj) b[nj] = *(const bf16x8*)(bp + nj * 32 * 128 + off);
#pragma unroll
        for (int mi = 0; mi < 2; ++mi)
#pragma unroll
            for (int nj = 0; nj < 4; ++nj) acc[mi][nj] = __builtin_amdgcn_mfma_f32_32x32x16_bf16(a[mi], b[nj], acc[mi][nj], 0, 0, 0);
    }
}

template <class AL, class BL>
__device__ __forceinline__ void gemm256_kloop(f32x16 (&acc)[2][4], const AL& al, const BL& bl, int nk, unsigned char* lds0, int t512) {
    const int srow = t512 >> 3;
    const int csrc = ((t512 & 7) ^ ((srow >> 1) & 7)) * 8;
#define G2_ISSUE(BUF, KT) { const int k_ = (KT) * 64 + csrc; _Pragma("unroll") for (int i = 0; i < 4; ++i) { \
        __builtin_amdgcn_global_load_lds((const unsigned*)al(srow + 64 * i, k_), (unsigned*)(lds0 + (BUF) * ST2_B + i * 8192 + t512 * 16), 16, 0, 0); \
        __builtin_amdgcn_global_load_lds((const unsigned*)bl(srow + 64 * i, k_), (unsigned*)(lds0 + (BUF) * ST2_B + 32768 + i * 8192 + t512 * 16), 16, 0, 0); } }
    const int last = nk - 1;
    __syncthreads();
    G2_ISSUE(0, 0);
    __syncthreads();
#pragma unroll 1
    for (int kt = 0; kt < nk; kt += 2) {
        G2_ISSUE(1, (kt + 1));
        compute_ktile256(acc, lds0, lds0 + 32768, t512);
        __syncthreads();
        G2_ISSUE(0, (kt + 2 < last ? kt + 2 : last));
        compute_ktile256(acc, lds0 + ST2_B, lds0 + ST2_B + 32768, t512);
        __syncthreads();
    }
#undef G2_ISSUE
}

#define ROWU(mi, reg) (wm * 64 + (mi) * 32 + 8 * ((reg) >> 2) + ((reg) & 3))
__device__ __forceinline__ void zero_acc256(f32x16 (&acc)[2][4]) {
#pragma unroll
    for (int i = 0; i < 2; ++i)
#pragma unroll
        for (int j = 0; j < 4; ++j)
#pragma unroll
            for (int e = 0; e < 16; ++e) acc[i][j][e] = 0.f;
}
__device__ __forceinline__ bool tile256(int it, int NT, int ntiles, int& mt, int& nt) {
    const int G = gridDim.x, b = blockIdx.x;
    if ((G & 7) == 0) {
        const int s = it * (G >> 3) + (b >> 3);
        if (s >= (ntiles >> 3)) return false;
        mt = (s / NT) * 8 + (b & 7); nt = s % NT;
    } else {
        const int t = it * G + b;
        if (t >= ntiles) return false;
        mt = t / NT; nt = t % NT;
    }
    return true;
}
__device__ __forceinline__ bool tile256_in(int it, int NT, int& mt, int& nt) {
    const int G = gridDim.x, b = blockIdx.x;
    if ((G & 7) == 0) {
        const int NG = NT >> 2;
        const int s = it * (G >> 3) + (b >> 3);
        const int ml = s / NG;
        if (ml >= 192) return false;
        const int x = b & 7;
        mt = (x >> 2) * 192 + ml; nt = (x & 3) * NG + (s - ml * NG);
    } else {
        const int t = it * G + b;
        if (t >= 384 * NT) return false;
        mt = t / NT; nt = t % NT;
    }
    return true;
}

__device__ __forceinline__ void zero_acc(f32x16 (&acc)[2][2]) {
#pragma unroll
    for (int i = 0; i < 2; ++i)
#pragma unroll
        for (int j = 0; j < 2; ++j)
#pragma unroll
            for (int e = 0; e < 16; ++e) acc[i][j][e] = 0.f;
}

__device__ __forceinline__ void transpose_tile(const float* src, int K, int N, bf16_t* dst, int tile, unsigned char* lds, int wv) {
    float* tl = (float*)lds;
    const int ntn = N / 64;
    const int k0 = (tile / ntn) * 64, n0 = (tile % ntn) * 64;
    const int tid = tidx();
    __syncthreads();
#pragma unroll
    for (int i = 0; i < 4; ++i) {
        const int r = (tid >> 4) + 16 * i, c4 = (tid & 15) * 4;
        const float4 v = *(const float4*)(src + (size_t)(k0 + r) * N + n0 + c4);
        tl[r * 65 + c4 + 0] = v.x; tl[r * 65 + c4 + 1] = v.y; tl[r * 65 + c4 + 2] = v.z; tl[r * 65 + c4 + 3] = v.w;
    }
    __syncthreads();
#pragma unroll
    for (int i = 0; i < 2; ++i) {
        const int n = (tid >> 3) + 32 * i, k8 = (tid & 7) * 8;
        uint4 o;
        o.x = pk2(tl[(k8 + 0) * 65 + n], tl[(k8 + 1) * 65 + n]);
        o.y = pk2(tl[(k8 + 2) * 65 + n], tl[(k8 + 3) * 65 + n]);
        o.z = pk2(tl[(k8 + 4) * 65 + n], tl[(k8 + 5) * 65 + n]);
        o.w = pk2(tl[(k8 + 6) * 65 + n], tl[(k8 + 7) * 65 + n]);
        *(uint4*)(dst + (size_t)(n0 + n) * K + k0 + k8) = o;
    }
}

__device__ __forceinline__ void mod_tile(const Params& p, int tile, unsigned char* lds, int wv) {
    float* sc = (float*)lds;
    float* red = (float*)(lds + 49152);
    const int L = tile / 96, n0 = (tile % 96) * 32;
    const int tid = tidx();
    __syncthreads();
    for (int i = tid; i < 12 * 1024; i += 256) {
        const int b = i >> 10, k = i & 1023;
        sc[i] = siluf_(c_row(p, b)[k]);
    }
    __syncthreads();
    const int kg = tid >> 5, col = tid & 31;
    float a[12];
#pragma unroll
    for (int b = 0; b < 12; ++b) a[b] = 0.f;
    const float* w = p.w_mod + (size_t)L * 1024 * 3072 + n0 + col;
#pragma unroll 1
    for (int k0 = kg * 128; k0 < kg * 128 + 128; k0 += 8) {
        float wq[8];
#pragma unroll
        for (int u = 0; u < 8; ++u) wq[u] = w[(size_t)(k0 + u) * 3072];
#pragma unroll
        for (int u = 0; u < 8; ++u)
#pragma unroll
            for (int b = 0; b < 12; ++b) a[b] += sc[b * 1024 + k0 + u] * wq[u];
    }
#pragma unroll
    for (int b = 0; b < 12; ++b) red[(kg * 12 + b) * 32 + col] = a[b];
    __syncthreads();
    for (int i = tid; i < 12 * 32; i += 256) {
        const int b = i >> 5, c = i & 31;
        float s = 0.f;
#pragma unroll
        for (int g = 0; g < 8; ++g) s += red[(g * 12 + b) * 32 + c];
        float* mod = (float*)(p.ws + OFF_MOD);
        mod[((size_t)L * 12 + b) * 3072 + n0 + c] = s + p.b_mod[(size_t)L * 3072 + n0 + c];
    }
}

__device__ __forceinline__ void phase_prologue(const Params& p, unsigned char* lds, int hb, int wv) {
    bf16_t* W = (bf16_t*)(p.ws + OFF_W);
    const int NTR = 4736, NMOD = 384, NROT = 2048;
    for (int t = VB; t < NTR + NMOD + NROT; t += VG) {
        if (t < NTR) {
            const float* src; int K, N; bf16_t* dst; int tile;
            if (t < 1536)      { const int j = t / 768;          tile = t % 768;          src = p.w_in_ab + (size_t)j * 3145728; K = 1024; N = 3072; dst = W + W_IN_AB + (size_t)j * 3145728; }
            else if (t < 2048) { const int j = (t - 1536) / 256; tile = (t - 1536) % 256; src = p.w_out_ab + (size_t)j * 1048576; K = 1024; N = 1024; dst = W + W_OUT_AB + (size_t)j * 1048576; }
            else if (t < 2176) { const int j = (t - 2048) / 64;  tile = (t - 2048) % 64;  src = p.w_glu + (size_t)j * 262144; K = 512; N = 512; dst = W + W_GLU + (size_t)j * 262144; }
            else if (t < 4224) { const int j = (t - 2176) / 1024; tile = (t - 2176) % 1024; src = p.w_in_c + (size_t)j * 4194304; K = 1024; N = 4096; dst = W + W_IN_C + (size_t)j * 4194304; }
            else               { const int j = (t - 4224) / 256; tile = (t - 4224) % 256; src = p.w_out_c + (size_t)j * 1048576; K = 1024; N = 1024; dst = W + W_OUT_C + (size_t)j * 1048576; }
            transpose_tile(src, K, N, dst, tile, lds, wv);
        } else if (t < NTR + NMOD) {
            mod_tile(p, t - NTR, lds, wv);
        } else {
            const int idx = (t - NTR - NMOD) * 256 + tidx();
            const int pos = idx >> 6, i = idx & 63;
            const float inv = powf(10000.f, -(float)(2 * i) / 128.f);
            const float ang = (float)pos * inv;
            float s, c;
            sincosf(ang, &s, &c);
            ((float*)(p.ws + OFF_COS))[idx] = c;
            ((float*)(p.ws + OFF_SIN))[idx] = s;
        }
    }
}

__device__ __forceinline__ void phase_norm(const Params& p, int L, int hb, int wv) {
    const int tid = tidx();
    const int lane = tid & 63, wave = tid >> 6;
    bf16_t* B = (bf16_t*)(p.ws + OFF_B);
    const float* mod = (const float*)(p.ws + OFF_MOD);
#define XBF(r) ((bf16_t*)((unsigned char*)p.out + (size_t)(r) * 4096 + 2048))
    float4 xn[4];
    uint2 xbn[4] = {make_uint2(0u, 0u), make_uint2(0u, 0u), make_uint2(0u, 0u), make_uint2(0u, 0u)};
    uint2 yn[4];
    {
        const int row = VB * 4 + wave;
#pragma unroll
        for (int i = 0; i < 4; ++i) {
            if (L <= 1) xn[i] = *(const float4*)(x_row(p, row) + i * 256 + lane * 4);
            else { xbn[i] = *(const uint2*)(XBF(row) + i * 256 + lane * 4); xn[i] = make_float4(0.f, 0.f, 0.f, 0.f); }
            yn[i] = (L >= 1) ? *(const uint2*)(B + (size_t)row * DM + i * 256 + lane * 4) : make_uint2(0u, 0u);
        }
    }
    float4 g4a[4], n4a[4], sha[4], scla[4], npa[4];
#pragma unroll
    for (int i = 0; i < 4; ++i) {
        g4a[i] = n4a[i] = sha[i] = scla[i] = npa[i] = make_float4(0.f, 0.f, 0.f, 0.f);
        if (L >= 1) n4a[i] = *(const float4*)(p.norm_post + (size_t)(L - 1) * DM + i * 256 + lane * 4);
        if (L <= 3) npa[i] = *(const float4*)(p.norm_pre + (size_t)L * DM + i * 256 + lane * 4);
    }
    int bprev = -1;
    for (int t = VB; t < T_TOK / 4; t += VG) {
        const int row = t * 4 + wave;
        const int b = row / SEQL;
        if (b != bprev) {
            bprev = b;
#pragma unroll
            for (int i = 0; i < 4; ++i) {
                if (L >= 1) g4a[i] = *(const float4*)(mod + ((size_t)(L - 1) * 12 + b) * 3072 + 2048 + i * 256 + lane * 4);
                if (L <= 3) {
                    sha[i] = *(const float4*)(mod + ((size_t)L * 12 + b) * 3072 + i * 256 + lane * 4);
                    scla[i] = *(const float4*)(mod + ((size_t)L * 12 + b) * 3072 + 1024 + i * 256 + lane * 4);
                }
            }
        }
        float x[16], y[16];
#pragma unroll
        for (int i = 0; i < 4; ++i) {
            if (L <= 1) { x[4 * i] = xn[i].x; x[4 * i + 1] = xn[i].y; x[4 * i + 2] = xn[i].z; x[4 * i + 3] = xn[i].w; }
            else {
                x[4 * i] = __uint_as_float(xbn[i].x << 16); x[4 * i + 1] = __uint_as_float(xbn[i].x & 0xffff0000u);
                x[4 * i + 2] = __uint_as_float(xbn[i].y << 16); x[4 * i + 3] = __uint_as_float(xbn[i].y & 0xffff0000u);
            }
            y[4 * i] = __uint_as_float(yn[i].x << 16); y[4 * i + 1] = __uint_as_float(yn[i].x & 0xffff0000u);
            y[4 * i + 2] = __uint_as_float(yn[i].y << 16); y[4 * i + 3] = __uint_as_float(yn[i].y & 0xffff0000u);
        }
        {
            const int tn = (t + VG < T_TOK / 4) ? t + VG : t;
            const int rown = tn * 4 + wave;
#pragma unroll
            for (int i = 0; i < 4; ++i) {
                if (L <= 1) xn[i] = *(const float4*)(x_row(p, rown) + i * 256 + lane * 4);
                else xbn[i] = *(const uint2*)(XBF(rown) + i * 256 + lane * 4);
                if (L >= 1) yn[i] = *(const uint2*)(B + (size_t)rown * DM + i * 256 + lane * 4);
            }
        }
        if (L >= 1) {
            float ss = 0.f;
#pragma unroll
            for (int e = 0; e < 16; ++e) ss += y[e] * y[e];
#pragma unroll
            for (int o = 32; o >= 1; o >>= 1) ss += __shfl_xor(ss, o);
            const float ry = rsqrtf(ss * (1.f / 1024.f) + EPSF);
#pragma unroll
            for (int i = 0; i < 4; ++i) {
                const int c = i * 256 + lane * 4;
                const float4 g4 = g4a[i];
                const float4 n4 = n4a[i];
                x[4 * i + 0] += g4.x * (y[4 * i + 0] * ry * n4.x);
                x[4 * i + 1] += g4.y * (y[4 * i + 1] * ry * n4.y);
                x[4 * i + 2] += g4.z * (y[4 * i + 2] * ry * n4.z);
                x[4 * i + 3] += g4.w * (y[4 * i + 3] * ry * n4.w);
                if (L == 4) {
                    float4 o; o.x = x[4 * i]; o.y = x[4 * i + 1]; o.z = x[4 * i + 2]; o.w = x[4 * i + 3];
                    *(float4*)(p.out + (size_t)row * DM + c) = o;
                } else {
                    st4(XBF(row) + c, x[4 * i], x[4 * i + 1], x[4 * i + 2], x[4 * i + 3]);
                }
            }
        }
        if (L <= 3) {
            float ss = 0.f;
#pragma unroll
            for (int e = 0; e < 16; ++e) ss += x[e] * x[e];
#pragma unroll
            for (int o = 32; o >= 1; o >>= 1) ss += __shfl_xor(ss, o);
            const float rx = rsqrtf(ss * (1.f / 1024.f) + EPSF);
#pragma unroll
            for (int i = 0; i < 4; ++i) {
                const int c = i * 256 + lane * 4;
                const float4 sh = sha[i];
                const float4 scl = scla[i];
                const float4 n4 = npa[i];
                const float h0 = x[4 * i + 0] * rx * n4.x * (1.f + scl.x) + sh.x;
                const float h1 = x[4 * i + 1] * rx * n4.y * (1.f + scl.y) + sh.y;
                const float h2 = x[4 * i + 2] * rx * n4.z * (1.f + scl.z) + sh.z;
                const float h3 = x[4 * i + 3] * rx * n4.w * (1.f + scl.w) + sh.w;
                st4(B + (size_t)row * DM + c, h0, h1, h2, h3);
            }
        }
    }
}

__device__ __forceinline__ void phase_inproj_even(const Params& p, int j, unsigned char* lds0, int hb, int wv) {
    const bf16_t* H = (const bf16_t*)(p.ws + OFF_B);
    const bf16_t* Wt = (const bf16_t*)(p.ws + OFF_W) + W_IN_AB + (size_t)j * 3145728;
    bf16_t* Z = (bf16_t*)(p.ws + OFF_Z);
    bf16_t* VT = (bf16_t*)(p.ws + OFF_Z + ZE_VT);
    bf16_t* KT = (bf16_t*)(p.ws + OFF_Z + ZE_KT);
    const float* COS = (const float*)(p.ws + OFF_COS);
    const float* SIN = (const float*)(p.ws + OFF_SIN);
    const int t512 = t512x();
    for (int it = 0;; ++it) {
        int mt, nt;
        if (!tile256_in(it, 12, mt, nt)) break;
        const int m0 = mt * 256, n0 = nt * 256;
        const bf16_t* Hm = H + (size_t)m0 * 1024;
        const bf16_t* Wn = Wt + (size_t)n0 * 1024;
        auto al = [&](int r, int k) { return Hm + (unsigned)(r * 1024 + k); };
        auto bl = [&](int r, int k) { return Wn + (unsigned)(r * 1024 + k); };
        f32x16 acc[2][4];
        zero_acc256(acc);
        gemm256_kloop(acc, al, bl, 16, lds0, t512);
        int tq = t512;
        asm volatile("" : "+v"(tq));
        const int lane = tq & 63, wave = tq >> 6, wm = wave >> 1, wn = wave & 1, l31 = lane & 31, half = lane >> 5;
        const int cw = n0 + wn * 128;
        const int seg = cw >> 9;
        const int bb = m0 / SEQL;
        const int rbase = m0 + wm * 64 + 4 * half;
        if (seg == 2) {
#pragma unroll
            for (int mi = 0; mi < 2; ++mi)
#pragma unroll
                for (int nj = 0; nj < 4; ++nj) {
                    const int n = cw - 1024 + nj * 32 + l31;
#pragma unroll
                    for (int q4 = 0; q4 < 4; ++q4) {
                        const int pos = (rbase % SEQL) + mi * 32 + 8 * q4;
                        st4(VT + ((size_t)bb * 512 + n) * SEQL + pos, acc[mi][nj][4 * q4], acc[mi][nj][4 * q4 + 1], acc[mi][nj][4 * q4 + 2], acc[mi][nj][4 * q4 + 3]);
                    }
                }
        } else if (seg <= 1) {
            const float ksc = (seg == 1) ? 0.08838834764831845f : 1.f;
            const int hd = (cw & 511) >> 7;
#pragma unroll
            for (int mi = 0; mi < 2; ++mi)
#pragma unroll
                for (int nj = 0; nj < 2; ++nj) {
                    const int d = nj * 32 + l31;
#pragma unroll
                    for (int hq = 0; hq < 2; ++hq) {
                        float cc8[8], sn8[8];
#pragma unroll
                        for (int r8 = 0; r8 < 8; ++r8) {
                            const int pos = (rbase + mi * 32 + 8 * (hq * 2 + (r8 >> 2)) + (r8 & 3)) % SEQL;
                            cc8[r8] = COS[pos * 64 + d]; sn8[r8] = SIN[pos * 64 + d];
                        }
#pragma unroll
                        for (int qq = 0; qq < 2; ++qq) {
                            const int q4 = hq * 2 + qq;
                            float o1[4], o2[4];
                            const int row0 = rbase + mi * 32 + 8 * q4;
#pragma unroll
                            for (int r = 0; r < 4; ++r) {
                                const int row = row0 + r;
                                const float cc = cc8[qq * 4 + r], sn = sn8[qq * 4 + r];
                                const float x1 = acc[mi][nj][4 * q4 + r], x2 = acc[mi][nj + 2][4 * q4 + r];
                                o1[r] = (x1 * cc - x2 * sn) * ksc;
                                o2[r] = (x1 * sn + x2 * cc) * ksc;
                                Z[(size_t)row * ZE_LD + cw + d] = f2bf(o1[r]);
                                Z[(size_t)row * ZE_LD + cw + 64 + d] = f2bf(o2[r]);
                            }
                            if (seg == 1) {
                                bf16_t* kt = KT + ((size_t)(bb * 4 + hd) * 128) * SEQL + (row0 % SEQL);
                                st4(kt + (size_t)d * SEQL, o1[0], o1[1], o1[2], o1[3]);
                                st4(kt + (size_t)(64 + d) * SEQL, o2[0], o2[1], o2[2], o2[3]);
                            }
                        }
                    }
                }
        } else if (seg == 4) {
            bf16_t* US = (bf16_t*)(p.ws + OFF_Z + ZE_US);
#pragma unroll
            for (int mi = 0; mi < 2; ++mi)
#pragma unroll
                for (int nj = 0; nj < 4; ++nj) {
                    const int n = cw - 2048 + nj * 32 + l31;
                    const int g = n >> 4, i = n & 15;
#pragma unroll
                    for (int reg = 0; reg < 16; ++reg) {
                        const int row = rbase + mi * 32 + 8 * (reg >> 2) + (reg & 3);
                        US[(((size_t)(row >> 6) * 32 + g) * 64 + (row & 63)) * 16 + i] = f2bf(acc[mi][nj][reg]);
                    }
                }
        } else {
            const int cb = (seg == 3) ? cw - 512 : cw - 1024;
#pragma unroll
            for (int mi = 0; mi < 2; ++mi)
#pragma unroll
                for (int nj = 0; nj < 4; ++nj) {
                    const int col = cb + nj * 32 + l31;
#pragma unroll
                    for (int reg = 0; reg < 16; ++reg) {
                        const int row = rbase + mi * 32 + 8 * (reg >> 2) + (reg & 3);
                        Z[(size_t)row * ZE_LD + col] = f2bf(acc[mi][nj][reg]);
                    }
                }
        }
    }
}

__device__ __forceinline__ void phase_inproj_odd(const Params& p, int j, unsigned char* lds0, int hb, int wv) {
    const bf16_t* H = (const bf16_t*)(p.ws + OFF_B);
    const bf16_t* Wt = (const bf16_t*)(p.ws + OFF_W) + W_IN_C + (size_t)j * 4194304;
    bf16_t* Z = (bf16_t*)(p.ws + OFF_Z);
    bf16_t* VT = (bf16_t*)(p.ws + OFF_Z + ZO_VT);
    const int t512 = t512x();
    for (int it = 0;; ++it) {
        int mt, nt;
        if (!tile256_in(it, 16, mt, nt)) break;
        const int m0 = mt * 256, n0 = nt * 256;
        const bf16_t* Hm = H + (size_t)m0 * 1024;
        const bf16_t* Wn = Wt + (size_t)n0 * 1024;
        auto al = [&](int r, int k) { return Hm + (unsigned)(r * 1024 + k); };
        auto bl = [&](int r, int k) { return Wn + (unsigned)(r * 1024 + k); };
        f32x16 acc[2][4];
        zero_acc256(acc);
        gemm256_kloop(acc, al, bl, 16, lds0, t512);
        int tq = t512;
        asm volatile("" : "+v"(tq));
        const int lane = tq & 63, wm = wv >> 1, wn = wv & 1, l31 = lane & 31, half = lane >> 5;
        const int cw = n0 + wn * 128;
        const int seg = cw >> 10;
        if (seg == 2) {
            const int bb = m0 / SEQL, p0 = m0 % SEQL;
            const unsigned lo = (unsigned)(l31 * SEQL + 4 * half);
#pragma unroll
            for (int mi = 0; mi < 2; ++mi)
#pragma unroll
                for (int nj = 0; nj < 4; ++nj) {
                    bf16_t* vb = VT + ((size_t)bb * 1024 + (cw - 2048 + nj * 32)) * SEQL + p0 + wm * 64 + mi * 32;
#pragma unroll
                    for (int q4 = 0; q4 < 4; ++q4)
                        st4(vb + 8 * q4 + lo, acc[mi][nj][4 * q4], acc[mi][nj][4 * q4 + 1], acc[mi][nj][4 * q4 + 2], acc[mi][nj][4 * q4 + 3]);
                }
        } else {
            const float sc = (seg == 0) ? 0.125f : 1.f;
            const int cbase = (seg == 3) ? cw - 1024 : cw;
            const unsigned lo = (unsigned)(4 * half * ZO_LD + l31);
#pragma unroll
            for (int mi = 0; mi < 2; ++mi)
#pragma unroll
                for (int nj = 0; nj < 4; ++nj)
#pragma unroll
                    for (int reg = 0; reg < 16; ++reg) {
                        bf16_t* zb = Z + (size_t)(m0 + ROWU(mi, reg)) * ZO_LD + cbase + nj * 32;
                        zb[lo] = f2bf(acc[mi][nj][reg] * sc);
                    }
        }
    }
}

__device__ __forceinline__ void phase_outproj(const Params& p, int L, unsigned char* lds0, int hb, int wv) {
    const int j = L >> 1;
    const bool even = (L & 1) == 0;
    const bf16_t* Z = (const bf16_t*)(p.ws + OFF_Z);
    const bf16_t* Wt = (const bf16_t*)(p.ws + OFF_W) + (even ? W_OUT_AB : W_OUT_C) + (size_t)j * 1048576;
    bf16_t* Y = (bf16_t*)(p.ws + OFF_B);
    const bf16_t* OBp = (const bf16_t*)(p.ws + OFF_Z + ZE_US);
    const int ld = even ? ZE_LD : ZO_LD;
    const int t512 = t512x();
    for (int it = 0;; ++it) {
        int mt, nt;
        if (!tile256(it, 4, 384 * 4, mt, nt)) break;
        const int m0 = mt * 256, n0 = nt * 256;
        const bf16_t* OBm = OBp + (size_t)m0 * 512;
        const bf16_t* Zm = Z + (size_t)m0 * ld;
        const bf16_t* Wn = Wt + (size_t)n0 * 1024;
        auto al = [&](int r, int k) {
            if (even && k >= 512) return OBm + (unsigned)(r * 512 + (k - 512));
            return Zm + (unsigned)(r * ld + k);
        };
        auto bl = [&](int r, int k) { return Wn + (unsigned)(r * 1024 + k); };
        f32x16 acc[2][4];
        zero_acc256(acc);
        gemm256_kloop(acc, al, bl, 16, lds0, t512);
        int tq = t512;
        asm volatile("" : "+v"(tq));
        const int lane = tq & 63, wm = wv >> 1, wn = wv & 1, l31 = lane & 31, half = lane >> 5;
        {
            const unsigned lo = (unsigned)(4 * half * 1024 + l31);
#pragma unroll
            for (int mi = 0; mi < 2; ++mi)
#pragma unroll
                for (int nj = 0; nj < 4; ++nj)
#pragma unroll
                    for (int reg = 0; reg < 16; ++reg) {
                        bf16_t* yb = Y + (size_t)(m0 + ROWU(mi, reg)) * 1024 + n0 + wn * 128 + nj * 32;
                        yb[lo] = f2bf(acc[mi][nj][reg]);
                    }
        }
    }
}

__device__ __forceinline__ void cpow(float zre, float zim, float k, float& pr, float& pi) {
    const float mag = expf(k * zre);
    float s, c;
    sincosf(k * zim, &s, &c);
    pr = mag * c; pi = mag * s;
}

__device__ __forceinline__ void phase_s5consts(const Params& p, int j, unsigned char* lds, int hb, int wv) {
    bf16_t* KMAT = (bf16_t*)(p.ws + OFF_B + B_KMAT);
    bf16_t* EMAT = (bf16_t*)(p.ws + OFF_B + B_EMAT);
    float* sz = (float*)lds;
    float* sg = (float*)(lds + 4096);
    const int tid = tidx();
    const int NA_ = 32 * 8, NB_ = 32 * 8, NC_ = 32 * 8;
    for (int t = VB; t < NA_ + NB_ + NC_; t += VG) {
        int g, sub, type;
        if (t < NA_) { type = 0; g = t >> 3; sub = t & 7; }
        else if (t < NA_ + NB_) { type = 1; g = (t - NA_) >> 3; sub = (t - NA_) & 7; }
        else { type = 2; g = (t - NA_ - NB_) >> 3; sub = (t - NA_ - NB_) & 7; }
        __syncthreads();
        if (tid < 128) {
            const int dir = tid >> 6, pp = tid & 63;
            const size_t base = ((size_t)(j * 2 + dir) * 32 + g);
            const float delta = expf(p.log_step[base]);
            const float are = p.a_re[base * 64 + pp], aim = p.a_im[base * 64 + pp];
            const float zre = are * delta, zim = aim * delta;
            float abr, abi;
            cpow(zre, zim, 1.f, abr, abi);
            const float den = are * are + aim * aim;
            const float nre = abr - 1.f, nim = abi;
            sz[tid * 4 + 0] = zre; sz[tid * 4 + 1] = zim;
            sz[tid * 4 + 2] = (nre * are + nim * aim) / den;
            sz[tid * 4 + 3] = (nim * are - nre * aim) / den;
        }
        __syncthreads();
        if (type == 0) {
            const int tau0 = sub * 8;
            bf16_t* Kt = (bf16_t*)(lds + 16384);
            const int o = tid >> 4, i = tid & 15;
#pragma unroll 1
            for (int dir = 0; dir < 2; ++dir) {
                const int kmax = dir == 0 ? tau0 + 7 : 63 - tau0;
                const size_t base = ((size_t)(j * 2 + dir) * 32 + g);
                float* scb = (float*)(lds + 53248);
                __syncthreads();
                for (int e = tid; e < 1024; e += 256) {
                    scb[e] = p.c_re[base * 1024 + e];
                    scb[1024 + e] = p.c_im[base * 1024 + e];
                    scb[2048 + e] = p.b_re[base * 1024 + e];
                    scb[3072 + e] = p.b_im[base * 1024 + e];
                }
                const float* cre = scb + o * 64;
                const float* cim = scb + 1024 + o * 64;
                const float* bre = scb + 2048 + i;
                const float* bim = scb + 3072 + i;
#pragma unroll 1
                for (int k0 = 0; k0 <= kmax; k0 += 16) {
                    __syncthreads();
                    for (int e = tid; e < 16 * 64; e += 256) {
                        const int dd = e >> 6, pp = e & 63;
                        float pr, pi;
                        cpow(sz[(dir * 64 + pp) * 4], sz[(dir * 64 + pp) * 4 + 1], (float)(k0 + dd), pr, pi);
                        const float fr = sz[(dir * 64 + pp) * 4 + 2], fi = sz[(dir * 64 + pp) * 4 + 3];
                        sg[e * 2] = pr * fr - pi * fi;
                        sg[e * 2 + 1] = pr * fi + pi * fr;
                    }
                    __syncthreads();
                    float acc[16];
#pragma unroll
                    for (int dd = 0; dd < 16; ++dd) acc[dd] = 0.f;
                    for (int pp = 0; pp < 64; ++pp) {
                        const float cr = cre[pp], ci = cim[pp], br = bre[pp * 16], bi = bim[pp * 16];
                        const float wr = cr * br - ci * bi, wi = cr * bi + ci * br;
#pragma unroll
                        for (int dd = 0; dd < 16; ++dd) { const float2 gg = *(const float2*)(sg + (dd * 64 + pp) * 2); acc[dd] += gg.x * wr - gg.y * wi; }
                    }
#pragma unroll
                    for (int dd = 0; dd < 16; ++dd) {
                        const int k = k0 + dd;
                        if (k <= kmax) {
                            const int didx = (dir == 0 ? k : -k) - (tau0 - 63);
                            float v = acc[dd];
                            if (dir == 1 && k == 0) v += bf2f(Kt[didx * 256 + tid]);
                            Kt[didx * 256 + tid] = f2bf(v);
                        }
                    }
                }
            }
            __syncthreads();
            bf16_t* km = KMAT + (size_t)g * 1024 * 1280;
            for (int v = tid; v < 128 * 128; v += 256) {
                const int rowl = v >> 7, vv = v & 127;
                const int tau = tau0 + (rowl >> 4), oo = rowl & 15, s = vv >> 1, ih = vv & 1;
                const int didx = tau - s - (tau0 - 63);
                const uint4 val = *(const uint4*)(Kt + didx * 256 + oo * 16 + ih * 8);
                *(uint4*)(km + (size_t)(tau * 16 + oo) * 1280 + s * 16 + ih * 8) = val;
            }
        } else if (type == 1) {
            const int dir = tid >> 7, ri = (tid >> 6) & 1, pp = tid & 63;
            const size_t base = ((size_t)(j * 2 + dir) * 32 + g);
            bf16_t* km = KMAT + (size_t)g * 1024 * 1280;
            float cra[16], cia[16];
#pragma unroll
            for (int o = 0; o < 16; ++o) { cra[o] = p.c_re[(base * 16 + o) * 64 + pp]; cia[o] = p.c_im[(base * 16 + o) * 64 + pp]; }
#pragma unroll 1
            for (int u = 0; u < 8; ++u) {
                const int tau = sub * 8 + u;
                float pr, pi;
                const float kk = dir == 0 ? (float)(tau + 1) : (float)(64 - tau);
                cpow(sz[(dir * 64 + pp) * 4], sz[(dir * 64 + pp) * 4 + 1], kk, pr, pi);
#pragma unroll
                for (int o = 0; o < 16; ++o) {
                    const float cr = cra[o], ci = cia[o];
                    const float wr = cr * pr - ci * pi, wi = cr * pi + ci * pr;
                    km[(size_t)(tau * 16 + o) * 1280 + 1024 + tid] = f2bf(ri == 0 ? wr : -wi);
                }
            }
        } else {
            const int dir = tid >> 7, ri = (tid >> 6) & 1, pp = tid & 63;
            const float fr = sz[(dir * 64 + pp) * 4 + 2], fi = sz[(dir * 64 + pp) * 4 + 3];
            const size_t base = ((size_t)(j * 2 + dir) * 32 + g);
            const float* bre = p.b_re + (base * 64 + pp) * 16;
            const float* bim = p.b_im + (base * 64 + pp) * 16;
            float bra[16], bia[16];
#pragma unroll
            for (int i = 0; i < 16; ++i) { bra[i] = bre[i]; bia[i] = bim[i]; }
#pragma unroll 1
            for (int u = 0; u < 8; ++u) {
                const int s = sub * 8 + u;
                float pr, pi;
                const float kk = dir == 0 ? (float)(63 - s) : (float)s;
                cpow(sz[(dir * 64 + pp) * 4], sz[(dir * 64 + pp) * 4 + 1], kk, pr, pi);
                const float gr = pr * fr - pi * fi, gi = pr * fi + pi * fr;
                float v[16];
#pragma unroll
                for (int i = 0; i < 16; ++i) {
                    const float br = bra[i], bi = bia[i];
                    v[i] = ri == 0 ? (gr * br - gi * bi) : (gr * bi + gi * br);
                }
                uint4 o0, o1;
                o0.x = pk2(v[0], v[1]); o0.y = pk2(v[2], v[3]); o0.z = pk2(v[4], v[5]); o0.w = pk2(v[6], v[7]);
                o1.x = pk2(v[8], v[9]); o1.y = pk2(v[10], v[11]); o1.z = pk2(v[12], v[13]); o1.w = pk2(v[14], v[15]);
                bf16_t* em = EMAT + ((size_t)g * 256 + tid) * 1024 + s * 16;
                *(uint4*)em = o0;
                *(uint4*)(em + 8) = o1;
            }
        }
    }
}

__device__ __forceinline__ void phase_s5A(const Params& p, unsigned char* lds0, int hb, int wv) {
    const bf16_t* US = (const bf16_t*)(p.ws + OFF_Z + ZE_US);
    const bf16_t* EMAT = (const bf16_t*)(p.ws + OFF_B + B_EMAT);
    float* E = (float*)(p.ws + OFF_Z + ZE_E);
    const int t512 = t512x();
    for (int t = blockIdx.x; t < 32 * 6; t += gridDim.x) {
        const int g = t / 6, mt = t % 6, m0 = mt * 256;
        const bf16_t* USg = US + ((size_t)m0 * 32 + g) * 1024;
        const bf16_t* EMg = EMAT + (size_t)g * 256 * 1024;
        auto al = [&](int r, int k) { return USg + (unsigned)(r * 32768 + k); };
        auto bl = [&](int r, int k) { return EMg + (unsigned)(r * 1024 + k); };
        f32x16 acc[2][4];
        zero_acc256(acc);
        gemm256_kloop(acc, al, bl, 16, lds0, t512);
        int tq = t512;
        asm volatile("" : "+v"(tq));
        const int lane = tq & 63, wm = wv >> 1, wn = wv & 1, l31 = lane & 31, half = lane >> 5;
        const unsigned lo = (unsigned)(4 * half * 8192 + l31);
#pragma unroll
        for (int mi = 0; mi < 2; ++mi)
#pragma unroll
            for (int nj = 0; nj < 4; ++nj)
#pragma unroll
                for (int reg = 0; reg < 16; ++reg) {
                    float* eb = E + ((size_t)(m0 + ROWU(mi, reg)) * 32 + g) * 256 + wn * 128 + nj * 32;
                    eb[lo] = acc[mi][nj][reg];
                }
    }
}

__device__ __forceinline__ void phase_s5scan(const Params& p, int j, int hb, int wv) {
    const float* E = (const float*)(p.ws + OFF_Z + ZE_E);
    bf16_t* CARRY = (bf16_t*)(p.ws + OFF_Z + ZE_CARRY);
    for (int it = VB * 256 + tidx(); it < 12 * 32 * 2 * 64; it += VG * 256) {
        const int pp = it & 63, dir = (it >> 6) & 1, g = (it >> 7) & 31, b = it >> 12;
        const size_t base = ((size_t)(j * 2 + dir) * 32 + g);
        const float delta = expf(p.log_step[base]);
        const float zre = p.a_re[base * 64 + pp] * delta, zim = p.a_im[base * 64 + pp] * delta;
        float ar, ai;
        cpow(zre, zim, 64.f, ar, ai);
        float fr = 0.f, fi = 0.f;
#pragma unroll 1
        for (int s0 = 0; s0 < 128; s0 += 32) {
            float er[32], ei[32];
#pragma unroll
            for (int u = 0; u < 32; ++u) {
                const int n = dir == 0 ? (s0 + u) : 127 - (s0 + u);
                const size_t idx = ((size_t)(b * 128 + n) * 32 + g) * 256 + dir * 128 + pp;
                er[u] = E[idx]; ei[u] = E[idx + 64];
            }
#pragma unroll
            for (int u = 0; u < 32; ++u) {
                const int n = dir == 0 ? (s0 + u) : 127 - (s0 + u);
                const size_t idx = ((size_t)(b * 128 + n) * 32 + g) * 256 + dir * 128 + pp;
                CARRY[idx] = f2bf(fr);
                CARRY[idx + 64] = f2bf(fi);
                const float nr = ar * fr - ai * fi + er[u];
                const float ni = ar * fi + ai * fr + ei[u];
                fr = nr; fi = ni;
            }
        }
    }
}

__device__ __forceinline__ void phase_s5main(const Params& p, int j, unsigned char* lds0, int hb, int wv) {
    const bf16_t* US = (const bf16_t*)(p.ws + OFF_Z + ZE_US);
    const bf16_t* KMAT = (const bf16_t*)(p.ws + OFF_B + B_KMAT);
    const bf16_t* CARRY = (const bf16_t*)(p.ws + OFF_Z + ZE_CARRY);
    bf16_t* YG = (bf16_t*)(p.ws + OFF_B + B_YG);
    const int t512 = t512x();
    for (int t = blockIdx.x; t < 32 * 6 * 4; t += gridDim.x) {
        const int g = t / 24, mt = (t % 24) >> 2, nt = t & 3, m0 = mt * 256, n0 = nt * 256;
        const bf16_t* USg = US + ((size_t)m0 * 32 + g) * 1024;
        const bf16_t* CAg = CARRY + ((size_t)m0 * 32 + g) * 256;
        const bf16_t* KMg = KMAT + ((size_t)g * 1024 + n0) * 1280;
        auto al = [&](int r, int k) {
            if (k < 1024) return USg + (unsigned)(r * 32768 + k);
            return CAg + (unsigned)(r * 8192 + (k - 1024));
        };
        auto bl = [&](int r, int k) { return KMg + (unsigned)(r * 1280 + k); };
        f32x16 acc[2][4];
        zero_acc256(acc);
        gemm256_kloop(acc, al, bl, 20, lds0, t512);
        int tq = t512;
        asm volatile("" : "+v"(tq));
        const int lane = tq & 63, wm = wv >> 1, wn = wv & 1, l31 = lane & 31, half = lane >> 5;
        {
            const unsigned loU = (unsigned)(4 * half * 32768 + l31);
            const unsigned loY = (unsigned)(4 * half * 32768 + (l31 >> 4) * 512 + (l31 & 15));
            const float dsk = p.ssm_d[(size_t)j * 512 + g * 16 + (l31 & 15)];
            bf16_t uv[2][8];
#define S5_LOAD(Q, BUF) { const int mi_ = (Q) >> 3, nj_ = ((Q) >> 1) & 3, hq_ = (Q) & 1; const int nb_ = n0 + wn * 128 + nj_ * 32; \
            _Pragma("unroll") for (int r8 = 0; r8 < 8; ++r8) { const int reg = hq_ * 8 + r8; \
                uv[BUF][r8] = (US + ((size_t)(m0 + ROWU(mi_, reg)) * 32 + g) * 1024 + nb_)[loU]; } }
            S5_LOAD(0, 0);
#pragma unroll
            for (int q = 0; q < 16; ++q) {
                if (q + 1 < 16) S5_LOAD(q + 1, (q + 1) & 1);
                const int mi = q >> 3, nj = (q >> 1) & 3, hq = q & 1;
                const int nb = n0 + wn * 128 + nj * 32;
#pragma unroll
                for (int r8 = 0; r8 < 8; ++r8) {
                    const int reg = hq * 8 + r8;
                    bf16_t* yb = YG + ((size_t)(m0 + ROWU(mi, reg)) * 64 + (nb >> 4)) * 512 + g * 16;
                    yb[loY] = f2bf(gelu_tanh(acc[mi][nj][reg] + dsk * bf2f(uv[q & 1][r8])));
                }
            }
#undef S5_LOAD
        }
    }
}

__device__ __forceinline__ void phase_glu(const Params& p, int j, unsigned char* lds0, int hb, int wv) {
    const bf16_t* Z = (const bf16_t*)(p.ws + OFF_Z);
    bf16_t* OBp = (bf16_t*)(p.ws + OFF_Z + ZE_US);
    const bf16_t* YG = (const bf16_t*)(p.ws + OFF_B + B_YG);
    const bf16_t* Wt = (const bf16_t*)(p.ws + OFF_W) + W_GLU + (size_t)j * 262144;
    const int t512 = t512x();
    for (int t = blockIdx.x; t < 384 * 2; t += gridDim.x) {
        const int mt = t >> 1, nt = t & 1, m0 = mt * 256, n0 = nt * 256;
        const bf16_t* YGm = YG + (size_t)m0 * 512;
        const bf16_t* Wn = Wt + (size_t)n0 * 512;
        auto al = [&](int r, int k) { return YGm + (unsigned)(r * 512 + k); };
        auto bl = [&](int r, int k) { return Wn + (unsigned)(r * 512 + k); };
        f32x16 acc[2][4];
        zero_acc256(acc);
        gemm256_kloop(acc, al, bl, 8, lds0, t512);
        int tq = t512;
        asm volatile("" : "+v"(tq));
        const int lane = tq & 63, wm = wv >> 1, wn = wv & 1, l31 = lane & 31, half = lane >> 5;
        {
            const unsigned loY = (unsigned)(4 * half * 512 + l31), loZ = (unsigned)(4 * half * ZE_LD + l31);
            bf16_t yv[2][8], gv[2][8];
#define GLU_LOAD(Q, BUF) { const int mi_ = (Q) >> 3, nj_ = ((Q) >> 1) & 3, hq_ = (Q) & 1; const int cb_ = n0 + wn * 128 + nj_ * 32; \
            _Pragma("unroll") for (int r8 = 0; r8 < 8; ++r8) { const int reg = hq_ * 8 + r8; \
                yv[BUF][r8] = (YG + (size_t)(m0 + ROWU(mi_, reg)) * 512 + cb_)[loY]; \
                gv[BUF][r8] = (Z + (size_t)(m0 + ROWU(mi_, reg)) * ZE_LD + 1536 + cb_)[loZ]; } }
            GLU_LOAD(0, 0);
#pragma unroll
            for (int q = 0; q < 16; ++q) {
                if (q + 1 < 16) GLU_LOAD(q + 1, (q + 1) & 1);
                const int mi = q >> 3, nj = (q >> 1) & 3, hq = q & 1;
                const int cb = n0 + wn * 128 + nj * 32;
#pragma unroll
                for (int r8 = 0; r8 < 8; ++r8) {
                    const int reg = hq * 8 + r8;
                    (OBp + (size_t)(m0 + ROWU(mi, reg)) * 512 + cb)[loY] = f2bf(bf2f(yv[q & 1][r8]) * sigmoidf_(acc[mi][nj][reg]) * siluf_(bf2f(gv[q & 1][r8])));
                }
            }
#undef GLU_LOAD
        }
    }
}

__device__ __forceinline__ void phase_ret1(const Params& p, unsigned char* lds, int hb, int wv) {
    const bf16_t* VT = (const bf16_t*)(p.ws + OFF_Z + ZE_VT);
    const bf16_t* KT = (const bf16_t*)(p.ws + OFF_Z + ZE_KT);
    bf16_t* ST = (bf16_t*)(p.ws + OFF_B);
    const int tid = tidx();
    const int lane = tid & 63, wave = tid >> 6, wm = wave >> 1, wn = wave & 1, l31 = lane & 31, half = lane >> 5;
    for (int t = VB; t < 2 * 3072; t += VG) {
        const int dir = t / 3072, r3 = t % 3072, b = r3 / 256, n = (r3 >> 2) & 63, h = r3 & 3;
        const float l2g = log2_gamma(h);
        const bf16_t* vt = VT + ((size_t)(b * 4 + h) * 128) * SEQL + n * 128;
        const bf16_t* kt = KT + ((size_t)(b * 4 + h) * 128) * SEQL + n * 128;
        auto al = [&](int r, int k) {
            const uint4 v = *(const uint4*)(vt + (size_t)r * SEQL + k);
            float w[8];
#pragma unroll
            for (int e = 0; e < 8; ++e) w[e] = __builtin_amdgcn_exp2f(l2g * (dir == 0 ? (float)(128 - (k + e)) : (float)(k + e + 1)));
            uint4 o;
            o.x = pk2(__uint_as_float(v.x << 16) * w[0], __uint_as_float(v.x & 0xffff0000u) * w[1]);
            o.y = pk2(__uint_as_float(v.y << 16) * w[2], __uint_as_float(v.y & 0xffff0000u) * w[3]);
            o.z = pk2(__uint_as_float(v.z << 16) * w[4], __uint_as_float(v.z & 0xffff0000u) * w[5]);
            o.w = pk2(__uint_as_float(v.w << 16) * w[6], __uint_as_float(v.w & 0xffff0000u) * w[7]);
            return o;
        };
        auto bl = [&](int r, int k) { return *(const uint4*)(kt + (size_t)r * SEQL + k); };
        f32x16 acc[2][2];
        zero_acc(acc);
        gemm_kloop(acc, al, bl, 2, lds, tid);
        bf16_t* st = ST + ((((size_t)dir * 12 + b) * 64 + n) * 4 + h) * 16384;
#pragma unroll
        for (int mi = 0; mi < 2; ++mi) {
            const int e = wm * 64 + mi * 32 + l31;
#pragma unroll
            for (int nj = 0; nj < 2; ++nj)
#pragma unroll
                for (int q4 = 0; q4 < 4; ++q4) {
                    const int d = wn * 32 + nj * 64 + 8 * q4 + 4 * half;
                    st4(st + e * 128 + d, acc[mi][nj][4 * q4], acc[mi][nj][4 * q4 + 1], acc[mi][nj][4 * q4 + 2], acc[mi][nj][4 * q4 + 3]);
                }
        }
    }
}

__device__ __forceinline__ void phase_ret2(const Params& p, int hb, int wv) {
    bf16_t* ST = (bf16_t*)(p.ws + OFF_B);
    for (int it = VB * 256 + tidx(); it < 2 * 12 * 4 * 2048; it += VG * 256) {
        const int v = it & 2047, h = (it >> 11) & 3, bd = it >> 13;
        const int dir = bd / 12;
        const float dec = exp2f(128.f * log2_gamma(h));
        float c[8];
#pragma unroll
        for (int e = 0; e < 8; ++e) c[e] = 0.f;
#pragma unroll 1
        for (int s0 = 0; s0 < 64; s0 += 16) {
            uint4 kvv[16];
#pragma unroll
            for (int u = 0; u < 16; ++u) {
                const int n = dir == 0 ? (s0 + u) : 63 - (s0 + u);
                kvv[u] = *(const uint4*)(ST + (((size_t)bd * 64 + n) * 4 + h) * 16384 + v * 8);
            }
#pragma unroll
            for (int u = 0; u < 16; ++u) {
                const int n = dir == 0 ? (s0 + u) : 63 - (s0 + u);
                bf16_t* ptr = ST + (((size_t)bd * 64 + n) * 4 + h) * 16384 + v * 8;
                const uint4 kv = kvv[u];
                uint4 o;
                o.x = pk2(c[0], c[1]); o.y = pk2(c[2], c[3]); o.z = pk2(c[4], c[5]); o.w = pk2(c[6], c[7]);
                *(uint4*)ptr = o;
                c[0] = dec * c[0] + __uint_as_float(kv.x << 16); c[1] = dec * c[1] + __uint_as_float(kv.x & 0xffff0000u);
                c[2] = dec * c[2] + __uint_as_float(kv.y << 16); c[3] = dec * c[3] + __uint_as_float(kv.y & 0xffff0000u);
                c[4] = dec * c[4] + __uint_as_float(kv.z << 16); c[5] = dec * c[5] + __uint_as_float(kv.z & 0xffff0000u);
                c[6] = dec * c[6] + __uint_as_float(kv.w << 16); c[7] = dec * c[7] + __uint_as_float(kv.w & 0xffff0000u);
            }
        }
    }
}

__device__ __forceinline__ void phase_ret3(const Params& p, unsigned char* lds, int hb, int wv) {
    bf16_t* Z = (bf16_t*)(p.ws + OFF_Z);
    const bf16_t* VT = (const bf16_t*)(p.ws + OFF_Z + ZE_VT);
    const bf16_t* ST = (const bf16_t*)(p.ws + OFF_B);
    float2* stat = (float2*)(lds + 4 * STAGE_B);
    const int tid = tidx();
    const int lane = tid & 63, wave = tid >> 6, wm = wave >> 1, wn = wave & 1, l31 = lane & 31, half = lane >> 5;
    for (int t = VB; t < 3072; t += VG) {
        const int b = t / 256, n = (t >> 2) & 63, h = t & 3;
        const float l2g = log2_gamma(h);
        const size_t m0 = (size_t)b * SEQL + n * 128;
        const bf16_t* zq = Z + m0 * ZE_LD + h * 128;
        const bf16_t* zk = Z + m0 * ZE_LD + 512 + h * 128;
        const bf16_t* stf = ST + ((((size_t)0 * 12 + b) * 64 + n) * 4 + h) * 16384;
        const bf16_t* stb = ST + ((((size_t)1 * 12 + b) * 64 + n) * 4 + h) * 16384;
        const bf16_t* vt = VT + ((size_t)(b * 4 + h) * 128) * SEQL + n * 128;
        f32x16 acc[2][2], accS[2][2];
        zero_acc(accS);
        {
            auto al = [&](int r, int k) { return *(const uint4*)(zq + (size_t)r * ZE_LD + k); };
            auto bl = [&](int r, int k) { return *(const uint4*)(zk + (size_t)r * ZE_LD + k); };
            gemm_kloop1(accS, al, bl, 2, lds, tid);
        }
        float l2gp = l2g;
        asm volatile("" : "+v"(l2gp));
        int l31p = l31;
        asm volatile("" : "+v"(l31p));
#pragma unroll
        for (int mi = 0; mi < 2; ++mi) {
            const int i = wm * 64 + mi * 32 + l31p;
#pragma unroll
            for (int nj = 0; nj < 2; ++nj)
#pragma unroll
                for (int q4 = 0; q4 < 4; ++q4) {
                    const int jj = wn * 32 + nj * 64 + 8 * q4 + 4 * half;
                    float pv[4];
#pragma unroll
                    for (int r = 0; r < 4; ++r) {
                        const int dj = i - (jj + r);
                        pv[r] = accS[mi][nj][4 * q4 + r] * __builtin_amdgcn_exp2f(l2gp * (float)(dj < 0 ? -dj : dj));
                    }
                    uint2 o; o.x = pk2(pv[0], pv[1]); o.y = pk2(pv[2], pv[3]);
                    *(uint2*)(lds + (jj >> 6) * STAGE_B + i * LDS_PITCH + (jj & 63) * 2) = o;
                }
        }
        __builtin_amdgcn_sched_barrier(0);
        {
            const int srow = tid >> 3, skc = (tid & 7) * 8;
#pragma unroll
            for (int kt = 0; kt < 2; ++kt) {
                uint4 v[4];
#pragma unroll
                for (int i = 0; i < 4; ++i) v[i] = *(const uint4*)(vt + (size_t)(srow + 32 * i) * SEQL + kt * 64 + skc);
#pragma unroll
                for (int i = 0; i < 4; ++i) *(uint4*)(lds + 2 * STAGE_B + kt * STAGE_B + (srow + 32 * i) * LDS_PITCH + skc * 2) = v[i];
                __builtin_amdgcn_sched_barrier(0);
            }
        }
        __syncthreads();
        zero_acc(acc);
        compute_ktile(acc, lds, lds + 2 * STAGE_B, tid, true);
        compute_ktile(acc, lds + STAGE_B, lds + 3 * STAGE_B, tid, true);
#pragma unroll 1
        for (int dirsel = 0; dirsel < 2; ++dirsel) {
            const bf16_t* stp = dirsel == 0 ? stf : stb;
            auto al = [&](int r, int k) {
                const uint4 v = *(const uint4*)(zq + (size_t)r * ZE_LD + k);
                const float s = __builtin_amdgcn_exp2f(l2g * (dirsel == 0 ? (float)r : (float)(127 - r)));
                return scale8(v, s);
            };
            auto bl = [&](int r, int k) { return *(const uint4*)(stp + r * 128 + k); };
            gemm_kloop1(acc, al, bl, 2, lds, tid);
        }
        float s1[2], s2[2];
#pragma unroll
        for (int mi = 0; mi < 2; ++mi) {
            float a = 0.f, q = 0.f;
#pragma unroll
            for (int nj = 0; nj < 2; ++nj)
#pragma unroll
                for (int e = 0; e < 16; ++e) { const float v = acc[mi][nj][e]; a += v; q += v * v; }
            a += __shfl_xor(a, 32); q += __shfl_xor(q, 32);
            s1[mi] = a; s2[mi] = q;
            if (half == 0) stat[(wm * 64 + mi * 32 + l31) * 2 + wn] = make_float2(a, q);
        }
        __syncthreads();
#pragma unroll
        for (int mi = 0; mi < 2; ++mi) {
            const int i = wm * 64 + mi * 32 + l31;
            const float2 o = stat[i * 2 + (wn ^ 1)];
            const float mean = (s1[mi] + o.x) * (1.f / 128.f);
            const float var = (s2[mi] + o.y) * (1.f / 128.f) - mean * mean;
            const float rstd = rsqrtf(fmaxf(var, 0.f) + EPSF);
            bf16_t* zr = Z + (m0 + i) * ZE_LD;
            float gg[2][4][4];
#pragma unroll
            for (int nj = 0; nj < 2; ++nj)
#pragma unroll
                for (int q4 = 0; q4 < 4; ++q4) {
                    const int e = wn * 32 + nj * 64 + 8 * q4 + 4 * half;
                    ld4(zr + 1024 + h * 128 + e, gg[nj][q4][0], gg[nj][q4][1], gg[nj][q4][2], gg[nj][q4][3]);
                }
#pragma unroll
            for (int nj = 0; nj < 2; ++nj)
#pragma unroll
                for (int q4 = 0; q4 < 4; ++q4) {
                    const int e = wn * 32 + nj * 64 + 8 * q4 + 4 * half;
                    st4(zr + h * 128 + e,
                        (acc[mi][nj][4 * q4] - mean) * rstd * siluf_(gg[nj][q4][0]), (acc[mi][nj][4 * q4 + 1] - mean) * rstd * siluf_(gg[nj][q4][1]),
                        (acc[mi][nj][4 * q4 + 2] - mean) * rstd * siluf_(gg[nj][q4][2]), (acc[mi][nj][4 * q4 + 3] - mean) * rstd * siluf_(gg[nj][q4][3]));
                }
        }
        __syncthreads();
    }
}

__device__ __forceinline__ void phase_na(const Params& p, int j, unsigned char* lds, int hb, int wv) {
    bf16_t* Z = (bf16_t*)(p.ws + OFF_Z);
    const bf16_t* VT = (const bf16_t*)(p.ws + OFF_Z + ZO_VT);
    float* btab = (float*)(lds + 4 * STAGE_B);
    const int tid = tidx();
    const int lane = tid & 63, a = tid >> 6;
    const int l15 = lane & 15, g = lane >> 4;
    const int kw = (a == 0) ? 0 : (a == 1) ? 8 : (a == 2) ? 24 : 32;
    const int cq = a * 16 + l15;
    int cs = cq - 8; cs = cs < 0 ? 0 : (cs > 48 ? 48 : cs);
    const int srow = tid >> 3, sc8 = (tid & 7) * 8;
    const unsigned koff = (unsigned)(srow * ZO_LD + sc8), voff = (unsigned)(srow * SEQL + sc8);
    const bool xmap = (gridDim.x == 256);
    const int RPB = xmap ? 2 : 16;
    for (int it = 0;; ++it) {
        if (xmap && it >= 24) break;
        int bh, r0;
        if (xmap) { bh = it * 8 + (blockIdx.x & 7); r0 = ((blockIdx.x >> 3) * 2 + hb) * RPB; }
        else { const int c = it * VG + VB; if (c >= 192 * 8) break; bh = c >> 3; r0 = (c & 7) * 16; }
        const int b = bh >> 4, h = bh & 15;
        __syncthreads();
        for (int i = tid; i < 15 * 32; i += 256) {
            const int rr = i >> 5, cc = i & 31;
            btab[i] = cc < 31 ? p.rel_bias[(((size_t)j * 16 + h) * 15 + rr) * 31 + cc] : 0.f;
        }
        const bf16_t* vtb = VT + ((size_t)(b * 16 + h) * 64) * SEQL;
#pragma unroll 1
        for (int r = r0; r < r0 + RPB; ++r) {
            int rs = r - 4; rs = rs < 0 ? 0 : (rs > 120 ? 120 : rs);
            const size_t tokq = (size_t)b * SEQL + r * 64 + cq;
            bf16_t* zq = Z + tokq * ZO_LD + h * 64;
            u32x4 st[16];
            {
                const bf16_t* kbase = Z + ((size_t)b * SEQL + rs * 64) * ZO_LD + 1024 + h * 64;
#pragma unroll
                for (int i = 0; i < 16; ++i) st[i] = *(const u32x4*)(kbase + (size_t)(32 * i) * ZO_LD + koff);
            }
            const bf16x8 q0 = *(const bf16x8*)(zq + g * 8);
            const bf16x8 q1 = *(const bf16x8*)(zq + 32 + g * 8);
            __syncthreads();
#pragma unroll
            for (int i = 0; i < 16; ++i) *(u32x4*)(lds + (srow + 32 * i) * LDS_PITCH + sc8 * 2) = st[i];
            __syncthreads();
            f32x4 S[8][2];
#pragma unroll
            for (int kr = 0; kr < 8; ++kr) {
                const float* rbr = btab + (rs + kr - r + 7) * 32;
#pragma unroll
                for (int kb = 0; kb < 2; ++kb) {
                    const unsigned char* kp = lds + (kr * 64 + kw + kb * 16 + l15) * LDS_PITCH + g * 16;
                    const bf16x8 k0 = *(const bf16x8*)kp;
                    const bf16x8 k1 = *(const bf16x8*)(kp + 64);
                    f32x4 s = {0.f, 0.f, 0.f, 0.f};
                    s = __builtin_amdgcn_mfma_f32_16x16x32_bf16(k0, q0, s, 0, 0, 0);
                    s = __builtin_amdgcn_mfma_f32_16x16x32_bf16(k1, q1, s, 0, 0, 0);
#pragma unroll
                    for (int e = 0; e < 4; ++e) {
                        const int kc = kw + kb * 16 + 4 * g + e;
                        int dc = kc - cq + 15; dc = dc < 0 ? 0 : (dc > 30 ? 30 : dc);
                        const bool valid = (kc >= cs) && (kc < cs + 16);
                        s[e] = valid ? s[e] + rbr[dc] : -1e30f;
                    }
                    S[kr][kb] = s;
                }
            }
            u32x4 sv[16];
            const bf16_t* vbase = vtb + rs * 64;
#pragma unroll
            for (int i = 0; i < 8; ++i) {
                sv[i] = *(const u32x4*)(vbase + (size_t)(32 * (i & 1)) * SEQL + (i >> 1) * 64 + voff);
            }
            float mx = -1e30f;
#pragma unroll
            for (int kr = 0; kr < 8; ++kr)
#pragma unroll
                for (int kb = 0; kb < 2; ++kb)
#pragma unroll
                    for (int e = 0; e < 4; ++e) mx = fmaxf(mx, S[kr][kb][e]);
            mx = fmaxf(mx, __shfl_xor(mx, 16));
            mx = fmaxf(mx, __shfl_xor(mx, 32));
            const float nmxl = -mx * 1.4426950408889634f;
            float sum = 0.f;
            u32x4 P[8];
#pragma unroll
            for (int kr = 0; kr < 8; ++kr) {
                float ev[8];
#pragma unroll
                for (int kb = 0; kb < 2; ++kb)
#pragma unroll
                    for (int e = 0; e < 4; ++e) { ev[kb * 4 + e] = __builtin_amdgcn_exp2f(fmaf(S[kr][kb][e], 1.4426950408889634f, nmxl)); sum += ev[kb * 4 + e]; }
                P[kr].x = pk2(ev[0], ev[1]); P[kr].y = pk2(ev[2], ev[3]); P[kr].z = pk2(ev[4], ev[5]); P[kr].w = pk2(ev[6], ev[7]);
            }
#pragma unroll
            for (int i = 8; i < 16; ++i) {
                sv[i] = *(const u32x4*)(vbase + (size_t)(32 * (i & 1)) * SEQL + (i >> 1) * 64 + voff);
            }
            sum += __shfl_xor(sum, 16);
            sum += __shfl_xor(sum, 32);
            const float rinv = 1.f / sum;
            __syncthreads();
#pragma unroll
            for (int i = 0; i < 16; ++i) *(u32x4*)(lds + (srow + 32 * i) * LDS_PITCH + sc8 * 2) = sv[i];
            __syncthreads();
            f32x4 O[4];
#pragma unroll
            for (int blk = 0; blk < 4; ++blk) O[blk] = (f32x4){0.f, 0.f, 0.f, 0.f};
#pragma unroll
            for (int kr = 0; kr < 8; ++kr) {
                const bf16x8 pf = (bf16x8)P[kr];
#pragma unroll
                for (int blk = 0; blk < 4; ++blk) {
                    const unsigned char* vp = lds + (kr * 64 + blk * 16 + l15) * LDS_PITCH + (kw + 4 * g) * 2;
                    const uint2 lo = *(const uint2*)vp;
                    const uint2 hi = *(const uint2*)(vp + 32);
                    u32x4 vu; vu.x = lo.x; vu.y = lo.y; vu.z = hi.x; vu.w = hi.y;
                    O[blk] = __builtin_amdgcn_mfma_f32_16x16x32_bf16((bf16x8)vu, pf, O[blk], 0, 0, 0);
                }
            }
            const bf16_t* zg = Z + tokq * ZO_LD + 2048 + h * 64;
            float go[4][4];
#pragma unroll
            for (int blk = 0; blk < 4; ++blk) ld4(zg + blk * 16 + 4 * g, go[blk][0], go[blk][1], go[blk][2], go[blk][3]);
#pragma unroll
            for (int blk = 0; blk < 4; ++blk) {
                const int dh = blk * 16 + 4 * g;
                st4(zq + dh, O[blk][0] * rinv * siluf_(go[blk][0]), O[blk][1] * rinv * siluf_(go[blk][1]), O[blk][2] * rinv * siluf_(go[blk][2]), O[blk][3] * rinv * siluf_(go[blk][3]));
            }
        }
    }
}

constexpr int N_PHASES = 32;
__device__ __forceinline__ void run_phase(const Params& p, int ph, unsigned char* lds, unsigned char* lds0, int hb, int wv) {
    if (ph >= 100) return;
    if (ph == 0) { phase_prologue(p, lds, hb, wv); return; }
    if (ph == 31) { phase_norm(p, 4, hb, wv); return; }
    int q = ph - 1;
    const int pair = q / 15; q %= 15;
    if (q < 11) {
        const int L = pair * 2, j = pair;
        switch (q) {
            case 0: phase_norm(p, L, hb, wv); break;
            case 1: phase_inproj_even(p, j, lds0, hb, wv); break;
            case 2: phase_s5consts(p, j, lds, hb, wv); break;
            case 3: phase_s5A(p, lds0, hb, wv); break;
            case 4: phase_s5scan(p, j, hb, wv); break;
            case 5: phase_s5main(p, j, lds0, hb, wv); break;
            case 6: phase_glu(p, j, lds0, hb, wv); break;
            case 7: phase_ret1(p, lds, hb, wv); break;
            case 8: phase_ret2(p, hb, wv); break;
            case 9: phase_ret3(p, lds, hb, wv); break;
            default: phase_outproj(p, L, lds0, hb, wv); break;
        }
    } else {
        const int L = pair * 2 + 1, j = pair;
        switch (q - 11) {
            case 0: phase_norm(p, L, hb, wv); break;
            case 1: phase_inproj_odd(p, j, lds0, hb, wv); break;
            case 2: phase_na(p, j, lds, hb, wv); break;
            default: phase_outproj(p, L, lds0, hb, wv); break;
        }
    }
}

#ifndef PROBE_PH
#define PROBE_PH 0
#define PROBE_N 0
#endif
__device__ __forceinline__ void grid_barrier(unsigned* ctr, unsigned target, int wv) {
    asm volatile("s_waitcnt vmcnt(0)" ::: "memory");
    __syncthreads();
    if (wv == 0 && lane_id() == 0) {
        __builtin_amdgcn_fence(__ATOMIC_RELEASE, "agent");
        asm volatile("s_waitcnt vmcnt(0)" ::: "memory");
        __hip_atomic_fetch_add(ctr, 1u, __ATOMIC_RELAXED, __HIP_MEMORY_SCOPE_AGENT);
        while (__hip_atomic_load(ctr, __ATOMIC_RELAXED, __HIP_MEMORY_SCOPE_AGENT) < target) { }
        __builtin_amdgcn_fence(__ATOMIC_ACQUIRE, "agent");
        asm volatile("s_waitcnt vmcnt(0)" ::: "memory");
    }
    __syncthreads();
}

__global__ void __launch_bounds__(512, 2) fwd_megakernel(Params p_in, int n_extra, int probe_ph) {
    __shared__ __attribute__((aligned(16))) unsigned char lds_all[2 * LDS_TOTAL];
    const Params& p = p_in;
    const int wv = __builtin_amdgcn_readfirstlane((int)(threadIdx.x >> 6));
    const int hb = wv >> 2;
    unsigned char* lds = lds_all + hb * LDS_TOTAL;
    cg::grid_group grid = cg::this_grid();
    unsigned* bar = (unsigned*)(p.ws + OFF_BAR);
    if (blockIdx.x == 0 && threadIdx.x == 0) __hip_atomic_store(bar, 0u, __ATOMIC_RELAXED, __HIP_MEMORY_SCOPE_AGENT);
    const int total = N_PHASES + n_extra;
#pragma unroll 1
    for (int it = 0; it < total; ++it) {
        const int ph = it < N_PHASES ? it : probe_ph + (it - N_PHASES);
        run_phase(p, ph, lds, lds_all, hb, wv);
        if (it + 1 < total) {
            if (it == 0) grid.sync();
            else grid_barrier(bar, (unsigned)it * gridDim.x, wv);
        }
    }
}

extern "C" void kernel_launch(void* const* d_in, const int* in_sizes, int n_in, void* d_out, int out_size, void* d_ws, size_t ws_size,
                              hipStream_t stream) {
    static int grid_blocks = 0;
    if (!grid_blocks) {
        int dev = 0, cus = 0, per_cu = 0;
        hipGetDevice(&dev);
        hipDeviceGetAttribute(&cus, hipDeviceAttributeMultiprocessorCount, dev);
        hipOccupancyMaxActiveBlocksPerMultiprocessor(&per_cu, fwd_megakernel, 512, 0);
        if (per_cu < 1) per_cu = 1;
        if (per_cu > 1) per_cu = 1;
        grid_blocks = cus * per_cu;
    }
    Params p{};
    p.x_prompt = (const float*)d_in[0]; p.x_sample = (const float*)d_in[1]; p.c_prompt = (const float*)d_in[2]; p.c_sample = (const float*)d_in[3];
    p.norm_pre = (const float*)d_in[4]; p.norm_post = (const float*)d_in[5]; p.w_mod = (const float*)d_in[6]; p.b_mod = (const float*)d_in[7];
    p.w_in_ab = (const float*)d_in[8]; p.w_out_ab = (const float*)d_in[9]; p.a_re = (const float*)d_in[10]; p.a_im = (const float*)d_in[11];
    p.log_step = (const float*)d_in[12]; p.b_re = (const float*)d_in[13]; p.b_im = (const float*)d_in[14]; p.c_re = (const float*)d_in[15];
    p.c_im = (const float*)d_in[16]; p.ssm_d = (const float*)d_in[17]; p.w_glu = (const float*)d_in[18]; p.w_in_c = (const float*)d_in[19];
    p.w_out_c = (const float*)d_in[20]; p.rel_bias = (const float*)d_in[21];
    p.out = (float*)d_out; p.ws = (unsigned char*)d_ws;
    int n_extra = PROBE_N, probe_ph = PROBE_PH;
    void* args[] = {&p, &n_extra, &probe_ph};
    hipError_t e = hipLaunchCooperativeKernel((void*)fwd_megakernel, dim3(grid_blocks), dim3(512), args, 0, stream);
    if (e != hipSuccess) fprintf(stderr, "cooperative launch failed: %s (grid %d)\n", hipGetErrorString(e), grid_blocks);
}
```
